# Optimizing an MI355X kernel written in HIP

```python
import jax
import jax.numpy as jnp
from jax import lax
import numpy as np

D_MODEL = 1024
BATCH = 4
SEQ = 8192
DEPTH = 1

N_HEADS = 8
HEAD_DIM = D_MODEL // N_HEADS
ATTN_WIDTH = N_HEADS * HEAD_DIM
ROT_DIM = HEAD_DIM // 4
ROPE_THETA = 500000.0
MOBA_BLOCK = 256
MOBA_TOPK = 3
Q_CHUNK = 32
LRU_WIDTH = D_MODEL
LRU_BLOCKS = 4
LRU_BLOCK_WIDTH = LRU_WIDTH // LRU_BLOCKS
CONV_WIDTH = 4
LRU_C = 8.0
D_FF = 4 * D_MODEL
NORM_EPS = 1e-6
MASK_VALUE = -1e30
SPLITS = (ATTN_WIDTH, 2 * ATTN_WIDTH, 3 * ATTN_WIDTH,
          3 * ATTN_WIDTH + LRU_WIDTH, 3 * ATTN_WIDTH + 2 * LRU_WIDTH,
          3 * ATTN_WIDTH + 2 * LRU_WIDTH + D_MODEL)
IN_COLS = 3 * ATTN_WIDTH + 2 * LRU_WIDTH + 2 * D_MODEL

kernel_name = "hybrid_moba_rglru_sqrelu_layer"


def rms_norm(x, gain):
    xf = x.astype(jnp.float32)
    y = xf * lax.rsqrt(jnp.mean(xf * xf, axis=-1, keepdims=True) + NORM_EPS)
    return (y * gain.astype(jnp.float32)).astype(x.dtype)


def rope_tables(seq_len):
    inv_freq = ROPE_THETA ** (-jnp.arange(0, ROT_DIM, 2, dtype=jnp.float32) / ROT_DIM)
    ang = jnp.arange(seq_len, dtype=jnp.float32)[:, None] * inv_freq[None, :]
    return jnp.cos(ang), jnp.sin(ang)


def partial_rope(x, cos, sin):
    half = ROT_DIM // 2
    x1 = x[..., :half].astype(jnp.float32)
    x2 = x[..., half:ROT_DIM].astype(jnp.float32)
    rot = jnp.concatenate([x1 * cos - x2 * sin, x2 * cos + x1 * sin], axis=-1).astype(x.dtype)
    return jnp.concatenate([rot, x[..., ROT_DIM:]], axis=-1)


def moba_attention(q, k, v):
    b, h, s, dh = q.shape
    n_blocks = -(-s // MOBA_BLOCK)
    pad = n_blocks * MOBA_BLOCK - s
    kp = jnp.pad(k, ((0, 0), (0, 0), (0, pad), (0, 0)))
    vp = jnp.pad(v, ((0, 0), (0, 0), (0, pad), (0, 0)))
    kb = kp.reshape(b, h, n_blocks, MOBA_BLOCK, dh)
    vb = vp.reshape(b, h, n_blocks, MOBA_BLOCK, dh)
    k_mean = jnp.mean(kb.astype(jnp.float32), axis=3)
    top = min(MOBA_TOPK, n_blocks)
    scale = dh ** -0.5
    n_chunks = s // Q_CHUNK
    q_chunks = jnp.moveaxis(q.reshape(b, h, n_chunks, Q_CHUNK, dh), 2, 0)
    block_ids = jnp.arange(n_blocks)
    gather_blocks = jax.vmap(jax.vmap(lambda blocks, idx: blocks[idx]))

    def one_chunk(args):
        c, qc = args
        q_start = c * Q_CHUNK
        q_pos = q_start + jnp.arange(Q_CHUNK)
        q_block = q_start // MOBA_BLOCK
        gate = jnp.einsum("bhqd,bhnd->bhqn", qc.astype(jnp.float32), k_mean)
        gate = jnp.where(block_ids < q_block, gate, -jnp.inf)
        _, sel = lax.top_k(gate, top)
        sel_ok = jnp.arange(top) < q_block
        k_sel = gather_blocks(kb, sel)
        v_sel = gather_blocks(vb, sel)
        s_sel = jnp.einsum("bhqd,bhqjkd->bhqjk", qc, k_sel).astype(jnp.float32) * scale
        s_sel = jnp.where(sel_ok[:, None], s_sel, MASK_VALUE)
        s_sel = s_sel.reshape(b, h, Q_CHUNK, top * MOBA_BLOCK)
        k_own = lax.dynamic_slice_in_dim(kp, q_block * MOBA_BLOCK, MOBA_BLOCK, axis=2)
        v_own = lax.dynamic_slice_in_dim(vp, q_block * MOBA_BLOCK, MOBA_BLOCK, axis=2)
        key_pos = q_block * MOBA_BLOCK + jnp.arange(MOBA_BLOCK)
        s_own = jnp.einsum("bhqd,bhkd->bhqk", qc, k_own).astype(jnp.float32) * scale
        s_own = jnp.where(key_pos[None, :] <= q_pos[:, None], s_own, MASK_VALUE)
        p = jax.nn.softmax(jnp.concatenate([s_sel, s_own], axis=-1), axis=-1).astype(v.dtype)
        p_sel = p[..., :top * MOBA_BLOCK].reshape(b, h, Q_CHUNK, top, MOBA_BLOCK)
        p_own = p[..., top * MOBA_BLOCK:]
        return (jnp.einsum("bhqjk,bhqjkd->bhqd", p_sel, v_sel)
                + jnp.einsum("bhqk,bhkd->bhqd", p_own, v_own))

    out = lax.map(one_chunk, (jnp.arange(n_chunks, dtype=jnp.int32), q_chunks))
    return jnp.moveaxis(out, 0, 2).reshape(b, h, s, dh)


def causal_depthwise_conv(x, w, bias):
    s = x.shape[1]
    xp = jnp.pad(x, ((0, 0), (CONV_WIDTH - 1, 0), (0, 0)))
    y = bias
    for j in range(CONV_WIDTH):
        y = y + w[j] * xp[:, j:j + s]
    return y


def block_diag_linear(x, w, bias):
    b, s, _ = x.shape
    xg = x.reshape(b, s, LRU_BLOCKS, LRU_BLOCK_WIDTH)
    return jnp.einsum("bsgi,gij->bsgj", xg, w).reshape(b, s, LRU_WIDTH) + bias


def _linear_combine(left, right):
    a_l, b_l = left
    a_r, b_r = right
    return a_l * a_r, a_r * b_l + b_r


def rg_lru(x, w_a, b_a, w_i, b_i, lam):
    r = jax.nn.sigmoid(block_diag_linear(x, w_a, b_a).astype(jnp.float32))
    i = jax.nn.sigmoid(block_diag_linear(x, w_i, b_i).astype(jnp.float32))
    log_a = -LRU_C * r * jax.nn.softplus(-lam.astype(jnp.float32))
    a = jnp.exp(log_a)
    mult = jnp.sqrt(-jnp.expm1(2.0 * log_a))
    bx = mult * (i * x.astype(jnp.float32))
    _, h = lax.associative_scan(_linear_combine, (a, bx), axis=1)
    return h.astype(x.dtype)


def hybrid_mixer(u, w_in, conv_w, conv_b, w_rg_a, b_rg_a, w_rg_i, b_rg_i, lru_lambda,
                 w_branch_attn, w_branch_lru, w_out):
    b, s, _ = u.shape
    proj = jnp.einsum("bsd,dc->bsc", u, w_in)
    q, k, v, x_lru, g_lru, gate_attn, gate_lru = jnp.split(proj, list(SPLITS), axis=-1)

    def to_heads(t):
        return t.reshape(b, s, N_HEADS, HEAD_DIM).transpose(0, 2, 1, 3)

    cos, sin = rope_tables(s)
    qh = partial_rope(to_heads(q), cos, sin)
    kh = partial_rope(to_heads(k), cos, sin)
    attn = moba_attention(qh, kh, to_heads(v))
    attn = attn.transpose(0, 2, 1, 3).reshape(b, s, ATTN_WIDTH)
    y_attn = attn @ w_branch_attn

    xc = causal_depthwise_conv(x_lru, conv_w, conv_b)
    hl = rg_lru(xc, w_rg_a, b_rg_a, w_rg_i, b_rg_i, lru_lambda)
    y_lru = (hl * jax.nn.gelu(g_lru)) @ w_branch_lru

    merged = jax.nn.sigmoid(gate_attn) * y_attn + jax.nn.sigmoid(gate_lru) * y_lru
    return merged @ w_out


def setup_inputs(seed: int = 0) -> dict:
    key = jax.random.key(seed)
    ks = jax.random.split(key, 18)
    f32 = jnp.float32

    def nrm(k, shape, scale):
        return jax.random.normal(k, shape, f32) * scale

    def gain(k):
        return 1.0 + 0.05 * jax.random.normal(k, (DEPTH, D_MODEL), f32)

    a_init = jax.random.uniform(ks[10], (DEPTH, LRU_WIDTH), f32, 0.9, 0.999)
    return {
        "x": nrm(ks[0], (BATCH, SEQ, D_MODEL), 1.0),
        "attn_pre_norm": gain(ks[1]),
        "attn_post_norm": gain(ks[2]),
        "w_in": nrm(ks[3], (DEPTH, D_MODEL, IN_COLS), D_MODEL ** -0.5),
        "conv_w": nrm(ks[4], (DEPTH, CONV_WIDTH, LRU_WIDTH), CONV_WIDTH ** -0.5),
        "conv_b": nrm(ks[5], (DEPTH, LRU_WIDTH), 0.01),
        "w_rg_a": nrm(ks[6], (DEPTH, LRU_BLOCKS, LRU_BLOCK_WIDTH, LRU_BLOCK_WIDTH), LRU_BLOCK_WIDTH ** -0.5),
        "b_rg_a": nrm(ks[7], (DEPTH, LRU_WIDTH), 0.01),
        "w_rg_i": nrm(ks[8], (DEPTH, LRU_BLOCKS, LRU_BLOCK_WIDTH, LRU_BLOCK_WIDTH), LRU_BLOCK_WIDTH ** -0.5),
        "b_rg_i": nrm(ks[9], (DEPTH, LRU_WIDTH), 0.01),
        "lru_lambda": jnp.log(a_init) - jnp.log1p(-a_init),
        "w_branch_attn": nrm(ks[11], (DEPTH, ATTN_WIDTH, D_MODEL), ATTN_WIDTH ** -0.5),
        "w_branch_lru": nrm(ks[12], (DEPTH, LRU_WIDTH, D_MODEL), LRU_WIDTH ** -0.5),
        "w_out": nrm(ks[13], (DEPTH, D_MODEL, D_MODEL), D_MODEL ** -0.5),
        "mlp_pre_norm": gain(ks[14]),
        "mlp_post_norm": gain(ks[15]),
        "w_mlp_up": nrm(ks[16], (DEPTH, D_MODEL, D_FF), D_MODEL ** -0.5),
        "w_mlp_down": nrm(ks[17], (DEPTH, D_FF, D_MODEL), D_FF ** -0.5),
    }


def reference(x, attn_pre_norm, attn_post_norm, w_in, conv_w, conv_b, w_rg_a, b_rg_a,
              w_rg_i, b_rg_i, lru_lambda, w_branch_attn, w_branch_lru, w_out,
              mlp_pre_norm, mlp_post_norm, w_mlp_up, w_mlp_down):
    h = x
    for l in range(DEPTH):
        u = rms_norm(h, attn_pre_norm[l])
        mix = hybrid_mixer(u, w_in[l], conv_w[l], conv_b[l], w_rg_a[l], b_rg_a[l],
                           w_rg_i[l], b_rg_i[l], lru_lambda[l],
                           w_branch_attn[l], w_branch_lru[l], w_out[l])
        h = h + rms_norm(mix, attn_post_norm[l])
        u = rms_norm(h, mlp_pre_norm[l])
        m = jnp.square(jax.nn.relu(u @ w_mlp_up[l])) @ w_mlp_down[l]
        h = h + rms_norm(m, mlp_post_norm[l])
    return h
```

```cpp
#include <hip/hip_runtime.h>
#include <cstdio>
#include <cstdint>

#ifndef N_LAUNCH_MODE
#define N_LAUNCH_MODE 1
#endif

typedef unsigned short bf16_t;
typedef short bf16x8 __attribute__((ext_vector_type(8)));
typedef short bf16x4 __attribute__((ext_vector_type(4)));
typedef float f32x4 __attribute__((ext_vector_type(4)));
typedef float f32x16 __attribute__((ext_vector_type(16)));
typedef unsigned u32x4 __attribute__((ext_vector_type(4)));
typedef unsigned u32x2 __attribute__((ext_vector_type(2)));

constexpr int BATCH = 4, SEQ = 8192, DM = 1024, NH = 8, HD = 128, FF = 4096;
constexpr int T = BATCH * SEQ;
constexpr int NBLK = SEQ / 256;
constexpr int NBH = BATCH * NH;
constexpr int NTHR = 512, NWAVE = 8;
constexpr int LDS_BYTES = 147456;
constexpr float NORM_EPS = 1e-6f;
constexpr int NPHASE = 14;

constexpr size_t MiB = 1u << 20;
constexpr size_t WS_CTL = 0;
constexpr size_t WS_WIN = 1 * MiB;
constexpr size_t WS_WRG = 15 * MiB;
constexpr size_t WS_WBA = 16 * MiB, WS_WBL = 18 * MiB, WS_WOUT = 20 * MiB;
constexpr size_t WS_WUP = 22 * MiB;
constexpr size_t WS_WDN = 30 * MiB;
constexpr size_t WS_SLOT0 = 40 * MiB, SLOT_BYTES = 64 * MiB;
constexpr size_t SLOT_ELEMS = SLOT_BYTES / 2;
constexpr size_t WS_TAIL = 488 * MiB;
constexpr size_t WS_COS = WS_TAIL, WS_SIN = WS_TAIL + 512 * 1024;
constexpr size_t WS_KM = WS_TAIL + 1 * MiB;
constexpr size_t WS_CNT = WS_TAIL + 1 * MiB + 512 * 1024;
constexpr size_t WS_SUMLA = WS_TAIL + 2 * MiB, WS_SUMH = WS_TAIL + 3 * MiB;
constexpr size_t WS_LSE = WS_TAIL + 4 * MiB;
constexpr size_t WS_LIST = WS_TAIL + 7 * MiB;
constexpr size_t WS_C8 = WS_TAIL + 23 * MiB;
constexpr size_t WS_END = 512 * MiB;


struct Args { const float* in[18]; float* out; unsigned char* ws; int ph_lo, ph_hi; };

__device__ __forceinline__ unsigned cvt_pk_bf16(float lo, float hi) { unsigned r; asm volatile("v_cvt_pk_bf16_f32 %0, %1, %2" : "=v"(r) : "v"(lo), "v"(hi)); return r; }
__device__ __forceinline__ float bflo(unsigned w) { return __uint_as_float(w << 16); }
__device__ __forceinline__ float bfhi(unsigned w) { return __uint_as_float(w & 0xffff0000u); }
__device__ __forceinline__ float bf1(bf16_t u) { return __uint_as_float((unsigned)u << 16); }
__device__ __forceinline__ float sigmoidf_(float x) { return __builtin_amdgcn_rcpf(1.0f + __expf(-x)); }
__device__ __forceinline__ float gelu_tanh(float x) {
    const float z = 0.7978845608028654f * (x + 0.044715f * x * x * x);
    return x * sigmoidf_(2.0f * z);
}
__device__ __forceinline__ float wave_sum(float v) {
#pragma unroll
    for (int o = 1; o < 64; o <<= 1) v += __shfl_xor(v, o);
    return v;
}
__device__ __forceinline__ int crow(int r, int hi) { return (r & 3) + 8 * (r >> 2) + 4 * hi; }

struct Frame {
    unsigned char* lds; int tid, lane, wave, vcu, G;
    unsigned char* ws; float* out;
};

__host__ __device__ __forceinline__ int perm32(int rho) { const int n = rho >> 4, i = rho & 15; return 8 * (i >> 2) + 4 * n + (i & 3); }
struct Unit { int pm, pn, seg; };
struct Gemm { const bf16_t* A0; const bf16_t* A1; const bf16_t* B0; const bf16_t* B1; int lda, ldb, K, a_grp_shift, a_grp_stride; };

constexpr int NXCD = 8, WGM = 8;
struct StaticOrder {
    int nM, nN, nwg, G, c, dual;
    __device__ void init(int M, int N, int G_, int c_, int dual_) { nM = M / 256; nN = N / 256; nwg = nM * nN; G = G_; c = c_; dual = dual_; }
    __device__ bool next(int i, Unit& u) const {
        const int ip = dual ? (i >> 1) : i; u.seg = dual ? (i & 1) : 0;
        const long L = (long)ip * G + c; if (L >= nwg) return false;
        int wgid = (int)L; { const int q = nwg / NXCD, r = nwg % NXCD, xcd = wgid % NXCD, off = wgid / NXCD; wgid = (xcd < r ? xcd * (q + 1) : r * (q + 1) + (xcd - r) * q) + off; }
        const int nig = WGM * nN, gid = wgid / nig, fm = gid * WGM, gsz = (nM - fm) < WGM ? (nM - fm) : WGM;
        u.pm = fm + ((wgid % nig) % gsz); u.pn = (wgid % nig) / gsz; return true;
    }
};

template <class Epi, class Sched>
__device__ __forceinline__ void gemm_simple(unsigned char* lds, const Gemm g, const Sched& S, const Epi& E) {
    const int tid = threadIdx.x, wid = __builtin_amdgcn_readfirstlane(tid >> 6), lane = tid & 63, wr = wid >> 2, wc = wid & 3, fr = lane & 15, fq = lane >> 4;
    constexpr int RS = 80;
    unsigned char* As = lds; unsigned char* Bs = lds + 256 * RS;
    const int row = tid >> 2, c4 = tid & 3;
    const int brow = Epi::PERM ? ((row & ~31) + perm32(row & 31)) : row;
    Unit u;
    for (int ui = 0; S.next(ui, u); ++ui) {
        f32x4 acc[2][2][4][2];
#pragma unroll
        for (int a = 0; a < 2; ++a)
#pragma unroll
            for (int b = 0; b < 2; ++b)
#pragma unroll
                for (int m = 0; m < 4; ++m)
#pragma unroll
                    for (int n = 0; n < 2; ++n) acc[a][b][m][n] = (f32x4){0.f, 0.f, 0.f, 0.f};
        const bf16_t* A = (u.seg ? g.A1 : g.A0) + (size_t)u.pm * 256 * g.lda + (size_t)(u.pn >> g.a_grp_shift) * g.a_grp_stride + (size_t)row * g.lda + c4 * 8;
        const bf16_t* Bt = (u.seg ? g.B1 : g.B0) + (size_t)u.pn * 256 * g.ldb + (size_t)brow * g.ldb + c4 * 8;
        const size_t a128 = (size_t)128 * g.lda, b128 = (size_t)128 * g.ldb;
        for (int k0 = 0; k0 < g.K; k0 += 32) {
            const u32x4 va0 = *(const u32x4*)(A + k0), va1 = *(const u32x4*)(A + a128 + k0);
            const u32x4 vb0 = *(const u32x4*)(Bt + k0), vb1 = *(const u32x4*)(Bt + b128 + k0);
            __syncthreads();
            *(u32x4*)(As + row * RS + c4 * 16) = va0; *(u32x4*)(As + (row + 128) * RS + c4 * 16) = va1;
            *(u32x4*)(Bs + row * RS + c4 * 16) = vb0; *(u32x4*)(Bs + (row + 128) * RS + c4 * 16) = vb1;
            __syncthreads();
            bf16x8 Bf[2][2];
#pragma unroll
            for (int bj = 0; bj < 2; ++bj)
#pragma unroll
                for (int n = 0; n < 2; ++n) Bf[bj][n] = *(const bf16x8*)(Bs + (128 * bj + 32 * wc + 16 * n + fr) * RS + fq * 16);
#pragma unroll
            for (int ai = 0; ai < 2; ++ai) {
                bf16x8 Af[4];
#pragma unroll
                for (int m = 0; m < 4; ++m) Af[m] = *(const bf16x8*)(As + (128 * ai + 64 * wr + 16 * m + fr) * RS + fq * 16);
#pragma unroll
                for (int bj = 0; bj < 2; ++bj)
#pragma unroll
                    for (int m = 0; m < 4; ++m)
#pragma unroll
                        for (int n = 0; n < 2; ++n) acc[ai][bj][m][n] = __builtin_amdgcn_mfma_f32_16x16x32_bf16(Bf[bj][n], Af[m], acc[ai][bj][m][n], 0, 0, 0);
            }
        }
        asm volatile("" ::: "memory");
        E(acc, u, wr, wc, fr, fq);
    }
    __syncthreads();
}

template <int ACT, bool SPLIT, bool ROPE> struct EpiStore {
    static constexpr bool PERM = true;
    bf16_t* O; int ldc; const float* cosT; const float* sinT;
    __device__ __forceinline__ void operator()(const f32x4 (&acc)[2][2][4][2], const Unit& u, int wr, int wc, int fr, int fq) const {
        const int row0 = u.pm * 256 + wr * 64 + fr; int colt = u.pn * 256; bf16_t* base = O;
        if (SPLIT) { const int sidx = u.pn >> 2; const int slot = sidx + (sidx >= 2 ? 1 : 0); base = O + (size_t)slot * SLOT_ELEMS; colt = (u.pn & 3) * 256; }
        const int col0 = colt + wc * 32 + 8 * fq;
        const bool rope = ROPE && (u.pn < 8) && (wc == 0);
#pragma unroll
        for (int ai = 0; ai < 2; ++ai)
#pragma unroll
            for (int m = 0; m < 4; ++m) {
                const int row = row0 + ai * 128 + m * 16; bf16_t* rowp = base + (size_t)row * ldc + col0;
                f32x4 c0, c1, s0, s1;
                if (rope) { const int pos = row & (SEQ - 1); const float* cp = cosT + pos * 16 + 8 * (fq & 1); const float* sp = sinT + pos * 16 + 8 * (fq & 1);
                    c0 = *(const f32x4*)cp; c1 = *(const f32x4*)(cp + 4); s0 = *(const f32x4*)sp; s1 = *(const f32x4*)(sp + 4); }
#pragma unroll
                for (int bj = 0; bj < 2; ++bj) {
                    f32x4 v0 = acc[ai][bj][m][0], v1 = acc[ai][bj][m][1];
                    if (rope) {
                        f32x4 p0, p1;
#pragma unroll
                        for (int j = 0; j < 4; ++j) { p0[j] = __shfl_xor(v0[j], 32); p1[j] = __shfl_xor(v1[j], 32); }
                        if (fq < 2) { v0 = v0 * c0 - p0 * s0; v1 = v1 * c1 - p1 * s1; }
                        else        { v0 = v0 * c0 + p0 * s0; v1 = v1 * c1 + p1 * s1; }
                    }
                    if (ACT == 1) {
#pragma unroll
                        for (int j = 0; j < 4; ++j) { const float a = fmaxf(v0[j], 0.f), b = fmaxf(v1[j], 0.f); v0[j] = a * a; v1[j] = b * b; }
                    }
                    u32x4 w; w.x = cvt_pk_bf16(v0[0], v0[1]); w.y = cvt_pk_bf16(v0[2], v0[3]); w.z = cvt_pk_bf16(v1[0], v1[1]); w.w = cvt_pk_bf16(v1[2], v1[3]);
                    *(u32x4*)(rowp + bj * 128) = w;
                }
            }
    }
};

struct EpiRG {
    static constexpr bool PERM = true;
    const bf16_t* XC; bf16_t* LA; bf16_t* BX; const float* ba; const float* bi; const float* c8;
    __device__ __forceinline__ void operator()(const f32x4 (&acc)[2][2][4][2], const Unit& u, int wr, int wc, int fr, int fq) const {
        const int row0 = u.pm * 256 + wr * 64 + fr;
        const int ch0 = (u.pn >> 1) * 256 + (u.pn & 1) * 128 + wc * 32 + 8 * fq;
        float vba[8], vbi[8], vc8[8];
#pragma unroll
        for (int e = 0; e < 8; ++e) { vba[e] = ba[ch0 + e]; vbi[e] = bi[ch0 + e]; vc8[e] = c8[ch0 + e]; }
#pragma unroll
        for (int ai = 0; ai < 2; ++ai)
#pragma unroll
            for (int m = 0; m < 4; ++m) {
                const int row = row0 + ai * 128 + m * 16; const size_t off = (size_t)row * DM + ch0;
                const u32x4 xw = *(const u32x4*)(XC + off);
                float xc[8] = {bflo(xw.x), bfhi(xw.x), bflo(xw.y), bfhi(xw.y), bflo(xw.z), bfhi(xw.z), bflo(xw.w), bfhi(xw.w)};
                float la[8], bx[8];
#pragma unroll
                for (int e = 0; e < 8; ++e) {
                    const float rp = acc[ai][0][m][e >> 2][e & 3] + vba[e], ip = acc[ai][1][m][e >> 2][e & 3] + vbi[e];
                    const float r = sigmoidf_(rp), ig = sigmoidf_(ip);
                    const float l = vc8[e] * r;
                    const float x2 = 2.0f * l;
                    const float om = (x2 > -0.02f) ? -x2 * (1.0f + x2 * (0.5f + x2 * (1.0f / 6.0f))) : (1.0f - __expf(x2));
                    la[e] = l; bx[e] = __builtin_amdgcn_sqrtf(om) * ig * xc[e];
                }
                u32x4 w; w.x = cvt_pk_bf16(la[0], la[1]); w.y = cvt_pk_bf16(la[2], la[3]); w.z = cvt_pk_bf16(la[4], la[5]); w.w = cvt_pk_bf16(la[6], la[7]);
                *(u32x4*)(LA + off) = w;
                w.x = cvt_pk_bf16(bx[0], bx[1]); w.y = cvt_pk_bf16(bx[2], bx[3]); w.z = cvt_pk_bf16(bx[4], bx[5]); w.w = cvt_pk_bf16(bx[6], bx[7]);
                *(u32x4*)(BX + off) = w;
                asm volatile("" ::: "memory");
            }
    }
};

struct EpiBranch {
    static constexpr bool PERM = true;
    const bf16_t* GA; const bf16_t* GL; bf16_t* MG;
    __device__ __forceinline__ void operator()(const f32x4 (&acc)[2][2][4][2], const Unit& u, int wr, int wc, int fr, int fq) const {
        const int row0 = u.pm * 256 + wr * 64 + fr, col0 = u.pn * 256 + wc * 32 + 8 * fq;
        const bf16_t* gate = u.seg ? GL : GA;
#pragma unroll
        for (int ai = 0; ai < 2; ++ai)
#pragma unroll
            for (int m = 0; m < 4; ++m)
#pragma unroll
                for (int bj = 0; bj < 2; ++bj) {
                    const size_t off = (size_t)(row0 + ai * 128 + m * 16) * DM + col0 + bj * 128;
                    const u32x4 gw = *(const u32x4*)(gate + off);
                    const float gv[8] = {bflo(gw.x), bfhi(gw.x), bflo(gw.y), bfhi(gw.y), bflo(gw.z), bfhi(gw.z), bflo(gw.w), bfhi(gw.w)};
                    float pv[8] = {0.f, 0.f, 0.f, 0.f, 0.f, 0.f, 0.f, 0.f};
                    if (u.seg) { const u32x4 pw = *(const u32x4*)(MG + off);
                        pv[0] = bflo(pw.x); pv[1] = bfhi(pw.x); pv[2] = bflo(pw.y); pv[3] = bfhi(pw.y); pv[4] = bflo(pw.z); pv[5] = bfhi(pw.z); pv[6] = bflo(pw.w); pv[7] = bfhi(pw.w); }
                    float o[8];
#pragma unroll
                    for (int e = 0; e < 8; ++e) o[e] = pv[e] + sigmoidf_(gv[e]) * acc[ai][bj][m][e >> 2][e & 3];
                    u32x4 w; w.x = cvt_pk_bf16(o[0], o[1]); w.y = cvt_pk_bf16(o[2], o[3]); w.z = cvt_pk_bf16(o[4], o[5]); w.w = cvt_pk_bf16(o[6], o[7]);
                    *(u32x4*)(MG + off) = w;
                    asm volatile("" ::: "memory");
                }
    }
};

__device__ __forceinline__ unsigned f2bf(float f) { unsigned u = __float_as_uint(f); return (u + 0x7fffu + ((u >> 16) & 1u)) >> 16; }
__device__ __forceinline__ unsigned pk2(float lo, float hi) { return f2bf(lo) | (f2bf(hi) << 16); }
__device__ __forceinline__ void transpose_item(const float* W, int ldw, int k0, int n0, bf16_t* dst, int Kd, float* scr, int lane) {
#pragma unroll 8
    for (int i = 0; i < 32; ++i) { const int kk = 2 * i + (lane >> 5); scr[kk * 33 + (lane & 31)] = W[(size_t)(k0 + kk) * ldw + n0 + (lane & 31)]; }
    asm volatile("s_waitcnt lgkmcnt(0)" ::: "memory");
    const int c = lane & 7;
#pragma unroll
    for (int j = 0; j < 4; ++j) { const int n = (lane >> 3) + 8 * j; const float* s = scr + (8 * c) * 33 + n;
        u32x4 o; o.x = pk2(s[0 * 33], s[1 * 33]); o.y = pk2(s[2 * 33], s[3 * 33]); o.z = pk2(s[4 * 33], s[5 * 33]); o.w = pk2(s[6 * 33], s[7 * 33]);
        *(u32x4*)(dst + (size_t)n * Kd + k0 + 8 * c) = o; }
    asm volatile("s_waitcnt lgkmcnt(0)" ::: "memory");
}
__device__ __forceinline__ void rms_row_to_bf16(const float* xrow, const float* gain, bf16_t* orow, int lane) {
    const f32x4* xr = (const f32x4*)xrow + lane; const f32x4* gr = (const f32x4*)gain + lane;
    f32x4 v[4]; float s = 0.f;
#pragma unroll
    for (int j = 0; j < 4; ++j) { v[j] = xr[64 * j]; s += (v[j].x * v[j].x + v[j].y * v[j].y) + (v[j].z * v[j].z + v[j].w * v[j].w); }
    const float rs = 1.0f / sqrtf(wave_sum(s) * (1.0f / DM) + NORM_EPS);
    u32x2* o8 = (u32x2*)orow + lane;
#pragma unroll
    for (int j = 0; j < 4; ++j) { const f32x4 gv = gr[64 * j]; u32x2 w; w.x = cvt_pk_bf16(v[j].x * rs * gv.x, v[j].y * rs * gv.y); w.y = cvt_pk_bf16(v[j].z * rs * gv.z, v[j].w * rs * gv.w); o8[64 * j] = w; }
}

__device__ __forceinline__ void p0_prologue(const Frame& F, const Args& a) {
    float* scr = (float*)(F.lds + F.wave * 16384);
    const int gw = F.vcu * NWAVE + F.wave, NGW = F.G * NWAVE;
    bf16_t* WinT = (bf16_t*)(F.ws + WS_WIN); bf16_t* WrgT = (bf16_t*)(F.ws + WS_WRG);
    constexpr int I_IN = 16 * 224, I_RG = 256, I_SQ = 16 * 32, I_UP = 16 * 128, I_DN = 64 * 32;
    constexpr int NITEMS = I_IN + I_RG + 3 * I_SQ + I_UP + I_DN;
    for (int it = gw; it < NITEMS; it += NGW) {
        int r = it;
        if (r < I_IN) { const int kb = r / 224, nb = r % 224, n0 = nb * 32;
            const int drow = (n0 < 2048) ? n0 : (n0 < 3072 ? 6144 + (n0 - 2048) : n0 - 1024);
            transpose_item(a.in[3], 7168, kb * 64, n0, WinT + (size_t)drow * 1024, 1024, scr, F.lane); continue; }
        r -= I_IN;
        if (r < I_RG) { const int which = r >> 7, g = (r >> 5) & 3, q = r & 31, kb = q >> 3, nb = q & 7, n0 = nb * 32;
            const float* W = a.in[which ? 8 : 6] + (size_t)g * 65536;
            const int tile = 2 * g + (n0 >> 7), drow = tile * 256 + which * 128 + (n0 & 127);
            transpose_item(W, 256, kb * 64, n0, WrgT + (size_t)drow * 256, 256, scr, F.lane); continue; }
        r -= I_RG;
        if (r < 3 * I_SQ) { const int w = r / I_SQ, q = r % I_SQ, kb = q >> 5, nb = q & 31;
            const float* W = a.in[w == 0 ? 11 : (w == 1 ? 12 : 13)]; bf16_t* dst = (bf16_t*)(F.ws + (w == 0 ? WS_WBA : (w == 1 ? WS_WBL : WS_WOUT)));
            transpose_item(W, 1024, kb * 64, nb * 32, dst + (size_t)(nb * 32) * 1024, 1024, scr, F.lane); continue; }
        r -= 3 * I_SQ;
        if (r < I_UP) { const int kb = r >> 7, nb = r & 127;
            transpose_item(a.in[16], 4096, kb * 64, nb * 32, (bf16_t*)(F.ws + WS_WUP) + (size_t)(nb * 32) * 1024, 1024, scr, F.lane); continue; }
        r -= I_UP;
        { const int kb = r >> 5, nb = r & 31;
            transpose_item(a.in[17], 1024, kb * 64, nb * 32, (bf16_t*)(F.ws + WS_WDN) + (size_t)(nb * 32) * 4096, 4096, scr, F.lane); }
    }
    bf16_t* U = (bf16_t*)F.out;
    for (int m = gw; m < T; m += NGW) rms_row_to_bf16(a.in[0] + (size_t)m * DM, a.in[1], U + (size_t)m * DM, F.lane);
    const int gt = F.vcu * NTHR + F.tid, NGT = F.G * NTHR;
    float* cosT = (float*)(F.ws + WS_COS); float* sinT = (float*)(F.ws + WS_SIN);
    for (int e = gt; e < SEQ * 16; e += NGT) {
        const int pos = e >> 4, i = e & 15;
        const float inv = powf(500000.0f, -(float)i * (1.0f / 16.0f));
        const float ang = (float)pos * inv;
        double rev = (double)ang * 0.15915494309189535; rev -= rint(rev);
        const float fr = (float)rev;
        cosT[e] = __builtin_amdgcn_cosf(fr); sinT[e] = __builtin_amdgcn_sinf(fr);
    }
    float* c8 = (float*)(F.ws + WS_C8);
    for (int e = gt; e < DM; e += NGT) { const float lam = a.in[10][e]; c8[e] = -8.0f * log1pf(expf(-lam)); }
}

__device__ __forceinline__ void p2_conv_kmean(const Frame& F, const Args& a) {
    const bf16_t* XL = (const bf16_t*)(F.ws + WS_SLOT0 + 3 * SLOT_BYTES); bf16_t* XC = (bf16_t*)F.out;
    const float* cw = a.in[4]; const float* cb = a.in[5];
    {
        const int cg = F.tid & 127, rg = F.tid >> 7, ch = cg * 8;
        float w[4][8], bs[8];
#pragma unroll
        for (int j = 0; j < 4; ++j)
#pragma unroll
            for (int e = 0; e < 8; ++e) w[j][e] = cw[j * DM + ch + e];
#pragma unroll
        for (int e = 0; e < 8; ++e) bs[e] = cb[ch + e];
        for (int un = F.vcu; un < T / 64; un += F.G) {
            const int row0 = un * 64 + rg * 16; const int t0 = row0 & (SEQ - 1);
            u32x4 h0 = {0, 0, 0, 0}, h1 = {0, 0, 0, 0}, h2 = {0, 0, 0, 0};
            if (t0 >= 3) { h0 = *(const u32x4*)(XL + (size_t)(row0 - 3) * DM + ch); h1 = *(const u32x4*)(XL + (size_t)(row0 - 2) * DM + ch); h2 = *(const u32x4*)(XL + (size_t)(row0 - 1) * DM + ch); }
#pragma unroll 4
            for (int r = 0; r < 16; ++r) {
                const u32x4 cur = *(const u32x4*)(XL + (size_t)(row0 + r) * DM + ch);
                const u32x4 p0 = h0, p1 = h1, p2 = h2, p3 = cur;
                float o[8];
#pragma unroll
                for (int q = 0; q < 4; ++q) {
                    o[2 * q]     = bs[2 * q]     + w[0][2 * q] * bflo(p0[q])     + w[1][2 * q] * bflo(p1[q])     + w[2][2 * q] * bflo(p2[q])     + w[3][2 * q] * bflo(p3[q]);
                    o[2 * q + 1] = bs[2 * q + 1] + w[0][2 * q + 1] * bfhi(p0[q]) + w[1][2 * q + 1] * bfhi(p1[q]) + w[2][2 * q + 1] * bfhi(p2[q]) + w[3][2 * q + 1] * bfhi(p3[q]);
                }
                u32x4 ww; ww.x = cvt_pk_bf16(o[0], o[1]); ww.y = cvt_pk_bf16(o[2], o[3]); ww.z = cvt_pk_bf16(o[4], o[5]); ww.w = cvt_pk_bf16(o[6], o[7]);
                *(u32x4*)(XC + (size_t)(row0 + r) * DM + ch) = ww;
                h0 = h1; h1 = h2; h2 = cur;
            }
        }
    }
    {
        const bf16_t* K = (const bf16_t*)(F.ws + WS_SLOT0 + 1 * SLOT_BYTES); float* KM = (float*)(F.ws + WS_KM);
        float* red = (float*)F.lds;
        const int dg = F.tid & 15, rg = F.tid >> 4;
        for (int un = F.vcu; un < NBH * NBLK; un += F.G) {
            const int bh = un >> 5, n = un & 31, b = bh >> 3, h = bh & 7;
            const bf16_t* kp = K + (size_t)(b * SEQ + n * 256 + rg * 8) * DM + h * HD + dg * 8;
            float s[8] = {0.f, 0.f, 0.f, 0.f, 0.f, 0.f, 0.f, 0.f};
#pragma unroll
            for (int r = 0; r < 8; ++r) { const u32x4 kw = *(const u32x4*)(kp + (size_t)r * DM);
                s[0] += bflo(kw.x); s[1] += bfhi(kw.x); s[2] += bflo(kw.y); s[3] += bfhi(kw.y); s[4] += bflo(kw.z); s[5] += bfhi(kw.z); s[6] += bflo(kw.w); s[7] += bfhi(kw.w); }
            __syncthreads();
#pragma unroll
            for (int e = 0; e < 8; ++e) red[rg * 128 + dg * 8 + e] = s[e];
            __syncthreads();
            if (F.tid < 128) { float t = 0.f;
#pragma unroll 8
                for (int r = 0; r < 32; ++r) t += red[r * 128 + F.tid];
                KM[(size_t)un * 128 + F.tid] = t * (1.0f / 256.0f); }
        }
        __syncthreads();
    }
}

__device__ __forceinline__ void top3_insert(float v, int n, float& v0, float& v1, float& v2, int& i0, int& i1, int& i2) {
    const bool g0 = v > v0, g1 = v > v1, g2 = v > v2;
    const float nv2 = g1 ? v1 : (g2 ? v : v2); const int ni2 = g1 ? i1 : (g2 ? n : i2);
    const float nv1 = g0 ? v0 : (g1 ? v : v1); const int ni1 = g0 ? i0 : (g1 ? n : i1);
    const float nv0 = g0 ? v : v0;             const int ni0 = g0 ? n : i0;
    v0 = nv0; v1 = nv1; v2 = nv2; i0 = ni0; i1 = ni1; i2 = ni2;
}
__device__ __forceinline__ void p3_select(const Frame& F) {
    const bf16_t* Q = (const bf16_t*)(F.ws + WS_SLOT0); const float* KM = (const float*)(F.ws + WS_KM);
    int* CNT = (int*)(F.ws + WS_CNT); bf16_t* LIST = (bf16_t*)(F.ws + WS_LIST);
    float* kms = (float*)F.lds;
    int* cnt = (int*)(F.lds + 16384);
    float* xv = (float*)(F.lds + 16384 + 256);
    int* xi = (int*)(F.lds + 16384 + 256 + 3072);
    const int q = F.tid & 255, half = __builtin_amdgcn_readfirstlane(F.tid >> 8);
    for (int un = F.vcu * 4; un < F.vcu * 4 + 4 && un < NBH * NBLK; ++un) {
        const int bh = un >> 5, j = un & 31, b = bh >> 3, h = bh & 7;
        __syncthreads();
        { const f32x4* src = (const f32x4*)(KM + (size_t)bh * 4096); f32x4* dst = (f32x4*)kms; dst[F.tid] = src[F.tid]; dst[F.tid + 512] = src[F.tid + 512]; }
        if (F.tid < 32) cnt[F.tid] = 0;
        __syncthreads();
        const bf16_t* qp = Q + (size_t)(b * SEQ + j * 256 + q) * DM + h * HD;
        float acc[16];
#pragma unroll
        for (int i = 0; i < 16; ++i) acc[i] = 0.f;
        const int nb = half * 16;
        if (nb < j) {
            for (int dc = 0; dc < 16; ++dc) {
                const u32x4 qw = *(const u32x4*)(qp + dc * 8);
                const float qf[8] = {bflo(qw.x), bfhi(qw.x), bflo(qw.y), bfhi(qw.y), bflo(qw.z), bfhi(qw.z), bflo(qw.w), bfhi(qw.w)};
#pragma unroll
                for (int i = 0; i < 16; ++i) {
                    const f32x4 k0 = *(const f32x4*)(kms + (nb + i) * 128 + dc * 8), k1 = *(const f32x4*)(kms + (nb + i) * 128 + dc * 8 + 4);
                    acc[i] += qf[0] * k0.x + qf[1] * k0.y + qf[2] * k0.z + qf[3] * k0.w + qf[4] * k1.x + qf[5] * k1.y + qf[6] * k1.z + qf[7] * k1.w;
                }
            }
        }
        float v0 = -INFINITY, v1 = -INFINITY, v2 = -INFINITY; int i0 = 0, i1 = 0, i2 = 0;
#pragma unroll
        for (int i = 0; i < 16; ++i) { const int n = nb + i; const float v = (n < j) ? acc[i] : -INFINITY; top3_insert(v, n, v0, v1, v2, i0, i1, i2); }
        if (half == 1) { xv[q * 3] = v0; xv[q * 3 + 1] = v1; xv[q * 3 + 2] = v2; xi[q * 3] = i0; xi[q * 3 + 1] = i1; xi[q * 3 + 2] = i2; }
        __syncthreads();
        if (half == 0) {
            top3_insert(xv[q * 3], xi[q * 3], v0, v1, v2, i0, i1, i2);
            top3_insert(xv[q * 3 + 1], xi[q * 3 + 1], v0, v1, v2, i0, i1, i2);
            top3_insert(xv[q * 3 + 2], xi[q * 3 + 2], v0, v1, v2, i0, i1, i2);
            const int nr = j < 3 ? j : 3;
            if (0 < nr) { const int pos = atomicAdd(&cnt[i0], 1); LIST[((size_t)(bh * 32 + i0) * 32 + j) * 256 + pos] = (bf16_t)(q | (0 << 8)); }
            if (1 < nr) { const int pos = atomicAdd(&cnt[i1], 1); LIST[((size_t)(bh * 32 + i1) * 32 + j) * 256 + pos] = (bf16_t)(q | (1 << 8)); }
            if (2 < nr) { const int pos = atomicAdd(&cnt[i2], 1); LIST[((size_t)(bh * 32 + i2) * 32 + j) * 256 + pos] = (bf16_t)(q | (2 << 8)); }
        }
        __syncthreads();
        if (F.tid < 32) CNT[(bh * 32 + F.tid) * 32 + j] = cnt[F.tid];
    }
    __syncthreads();
}

template <int PASS> __device__ __forceinline__ void p45_scan(const Frame& F) {
    const bf16_t* LA = (const bf16_t*)((unsigned char*)F.out + SLOT_BYTES); const bf16_t* BX = (const bf16_t*)(F.ws + WS_SLOT0 + 3 * SLOT_BYTES);
    bf16_t* G = (bf16_t*)(F.ws + WS_SLOT0 + 4 * SLOT_BYTES);
    float* SLA = (float*)(F.ws + WS_SUMLA); float* SH = (float*)(F.ws + WS_SUMH);
    const int ch = F.tid * 2;
    for (int un = F.vcu; un < BATCH * 64; un += F.G) {
        const int b = un >> 6, c = un & 63;
        const size_t base = (size_t)(b * SEQ + c * 128) * DM + ch;
        float h0 = 0.f, h1 = 0.f, sl0 = 0.f, sl1 = 0.f;
        if (PASS == 2) {
            for (int cc = 0; cc < c; ++cc) { const size_t so = (size_t)(b * 64 + cc) * DM + ch;
                const float2 la = *(const float2*)(SLA + so), hh = *(const float2*)(SH + so);
                h0 = __expf(la.x) * h0 + hh.x; h1 = __expf(la.y) * h1 + hh.y; }
        }
#pragma unroll 8
        for (int r = 0; r < 128; ++r) {
            const unsigned lw = *(const unsigned*)(LA + base + (size_t)r * DM), bw = *(const unsigned*)(BX + base + (size_t)r * DM);
            const float l0 = bflo(lw), l1 = bfhi(lw);
            h0 = __expf(l0) * h0 + bflo(bw); h1 = __expf(l1) * h1 + bfhi(bw);
            if (PASS == 1) { sl0 += l0; sl1 += l1; }
            if (PASS == 2) { const unsigned gw = *(const unsigned*)(G + base + (size_t)r * DM);
                *(unsigned*)(G + base + (size_t)r * DM) = cvt_pk_bf16(h0 * gelu_tanh(bflo(gw)), h1 * gelu_tanh(bfhi(gw))); }
        }
        if (PASS == 1) { const size_t so = (size_t)un * DM + ch; *(float2*)(SLA + so) = make_float2(sl0, sl1); *(float2*)(SH + so) = make_float2(h0, h1); }
    }
}

constexpr int AT_KS = 0, AT_KROW = 272;
constexpr int AT_VS = 256 * AT_KROW, AT_VROW = 520;
constexpr int AT_ROWS = AT_VS + 128 * AT_VROW;
constexpr int AT_WSF = AT_ROWS + 1024;
constexpr int AT_MISC = AT_WSF + 4096;
static_assert(AT_MISC + 4096 + 1024 <= LDS_BYTES, "attention LDS map");
constexpr float SM_SCALE = 0.08838834764831845f;
constexpr float SM_C = SM_SCALE * 1.4426950408889634f;

__device__ __forceinline__ void attn_load_kv(const Frame& F, int bh, int n) {
    const int b = bh >> 3, h = bh & 7;
    const bf16_t* K = (const bf16_t*)(F.ws + WS_SLOT0 + 1 * SLOT_BYTES); const bf16_t* VT = (const bf16_t*)(F.ws + WS_SLOT0 + 2 * SLOT_BYTES);
    const size_t tok0 = (size_t)b * SEQ + n * 256;
#pragma unroll
    for (int p = 0; p < 8; ++p) { const int idx = p * 512 + F.tid, row = idx >> 4, c16 = idx & 15;
        const u32x4 v = *(const u32x4*)(K + (tok0 + row) * DM + h * HD + c16 * 8);
        *(u32x4*)(F.lds + AT_KS + row * AT_KROW + c16 * 16) = v; }
#pragma unroll
    for (int p = 0; p < 8; ++p) { const int idx = p * 512 + F.tid, d = idx >> 5, c16 = idx & 31;
        const u32x4 v = *(const u32x4*)(VT + (size_t)(h * HD + d) * T + tok0 + c16 * 8);
        u32x2* dst = (u32x2*)(F.lds + AT_VS + d * AT_VROW + c16 * 16); dst[0] = (u32x2){v.x, v.y}; dst[1] = (u32x2){v.z, v.w}; }
}

template <int MODE> __device__ __forceinline__ void attn_tile(const Frame& F, int bh, int jblk) {
    const int h = bh & 7, w = F.wave, lane = F.lane, c = lane & 31, hh = lane >> 5;
    const unsigned* ROWS = (const unsigned*)(F.lds + AT_ROWS);
    float* wsf = (float*)(F.lds + AT_WSF) + w * 128;
    bf16_t* Q = (bf16_t*)(F.ws + WS_SLOT0);
    float* LSE = (float*)(F.ws + WS_LSE);
    bf16_t* P0 = (bf16_t*)F.out; bf16_t* P1 = (bf16_t*)((unsigned char*)F.out + SLOT_BYTES); bf16_t* P2 = (bf16_t*)(F.ws + WS_SLOT0 + 3 * SLOT_BYTES);
    const unsigned myinfo = ROWS[32 * w + c];
    const unsigned mytok = myinfo & 0xfffffu;
    const int ng = (MODE == 1) ? (w + 1) : 8;
    bf16x8 qf[8];
    { const bf16_t* qp = Q + (size_t)mytok * DM + h * HD + 8 * hh;
#pragma unroll
      for (int s = 0; s < 8; ++s) qf[s] = *(const bf16x8*)(qp + 16 * s); }
    f32x16 o[4];
#pragma unroll
    for (int dg = 0; dg < 4; ++dg) {
#pragma unroll
        for (int i = 0; i < 16; ++i) o[dg][i] = 0.f;
    }
    float mx = -INFINITY, ls = 0.f;
    const int qlim = c - 4 * hh;
    for (int g = 0; g < ng; ++g) {
        f32x16 st;
#pragma unroll
        for (int i = 0; i < 16; ++i) st[i] = 0.f;
        { const unsigned char* kp = F.lds + AT_KS + (32 * g + c) * AT_KROW + 16 * hh;
#pragma unroll
          for (int s = 0; s < 8; ++s) { const bf16x8 kf = *(const bf16x8*)(kp + 32 * s); st = __builtin_amdgcn_mfma_f32_32x32x16_bf16(kf, qf[s], st, 0, 0, 0); } }
        if (MODE == 1 && g == w) {
#pragma unroll
            for (int i = 0; i < 16; ++i) { const int msk = (qlim - ((i & 3) + 8 * (i >> 2))) >> 31;
                st[i] = fminf(st[i], __uint_as_float(0x7f800000u | ((unsigned)msk & 0x80000000u))); }
        }
        float ml = st[0];
#pragma unroll
        for (int i = 1; i < 16; ++i) ml = fmaxf(ml, st[i]);
        ml = fmaxf(ml, __shfl_xor(ml, 32));
        const float mn = fmaxf(mx, ml);
        const float alpha = __builtin_amdgcn_exp2f((mx - mn) * SM_C);
        float p[16], ps = 0.f;
#pragma unroll
        for (int i = 0; i < 16; ++i) { p[i] = __builtin_amdgcn_exp2f((st[i] - mn) * SM_C); ps += p[i]; }
        ls = ls * alpha + ps;
        if (!__all(mn == mx)) {
            if (hh == 0) wsf[c] = alpha;
            asm volatile("s_waitcnt lgkmcnt(0)" ::: "memory");
#pragma unroll
            for (int i = 0; i < 16; ++i) { const float a = wsf[crow(i, hh)];
#pragma unroll
                for (int dg = 0; dg < 4; ++dg) o[dg][i] *= a; }
        }
        mx = mn;
        bf16x8 pf[2];
#pragma unroll
        for (int s2 = 0; s2 < 2; ++s2) { u32x4 pw; pw.x = cvt_pk_bf16(p[8 * s2], p[8 * s2 + 1]); pw.y = cvt_pk_bf16(p[8 * s2 + 2], p[8 * s2 + 3]); pw.z = cvt_pk_bf16(p[8 * s2 + 4], p[8 * s2 + 5]); pw.w = cvt_pk_bf16(p[8 * s2 + 6], p[8 * s2 + 7]);
            pf[s2] = __builtin_bit_cast(bf16x8, pw); }
#pragma unroll
        for (int s2 = 0; s2 < 2; ++s2) {
#pragma unroll
            for (int dg = 0; dg < 4; ++dg) {
                const unsigned char* vp = F.lds + AT_VS + (32 * dg + c) * AT_VROW + (32 * g + 16 * s2 + 4 * hh) * 2;
                const bf16x4 lo = *(const bf16x4*)vp, hi = *(const bf16x4*)(vp + 16);
                const bf16x8 vf = (bf16x8){lo[0], lo[1], lo[2], lo[3], hi[0], hi[1], hi[2], hi[3]};
                o[dg] = __builtin_amdgcn_mfma_f32_32x32x16_bf16(pf[s2], vf, o[dg], 0, 0, 0);
            }
        }
    }
    ls += __shfl_xor(ls, 32);
    const float lse_own = mx * SM_SCALE + __logf(ls);
    if (MODE == 0) {
        if (hh == 0) { wsf[c] = 1.0f / ls; }
        const unsigned rank = (myinfo >> 20) & 3u; const bool valid = (myinfo >> 31) != 0u;
        if (hh == 0 && valid) LSE[((size_t)rank * T + mytok) * NH + h] = lse_own;
        asm volatile("s_waitcnt lgkmcnt(0)" ::: "memory");
#pragma unroll
        for (int i = 0; i < 16; ++i) {
            const int qi = crow(i, hh); const unsigned info = ROWS[32 * w + qi];
            if (info >> 31) { const unsigned tok = info & 0xfffffu, rk = (info >> 20) & 3u; const float li = wsf[qi];
                bf16_t* pp = (rk == 0 ? P0 : (rk == 1 ? P1 : P2)) + (size_t)tok * DM + h * HD + c;
#pragma unroll
                for (int dg = 0; dg < 4; ++dg) pp[32 * dg] = (bf16_t)f2bf(o[dg][i] * li); }
        }
    } else {
        const int nr = jblk < 3 ? jblk : 3;
        if (hh == 0) {
            float l0 = -INFINITY, l1 = -INFINITY, l2 = -INFINITY;
            if (0 < nr) l0 = LSE[((size_t)0 * T + mytok) * NH + h];
            if (1 < nr) l1 = LSE[((size_t)1 * T + mytok) * NH + h];
            if (2 < nr) l2 = LSE[((size_t)2 * T + mytok) * NH + h];
            const float M = fmaxf(fmaxf(lse_own, l0), fmaxf(l1, l2));
            const float wo = __expf(lse_own - M), w0 = __expf(l0 - M), w1 = __expf(l1 - M), w2 = __expf(l2 - M);
            const float inv = 1.0f / (wo + w0 + w1 + w2);
            wsf[c] = wo * inv / ls; wsf[32 + c] = w0 * inv; wsf[64 + c] = w1 * inv; wsf[96 + c] = w2 * inv;
        }
        asm volatile("s_waitcnt lgkmcnt(0)" ::: "memory");
#pragma unroll
        for (int i = 0; i < 16; ++i) {
            const int qi = crow(i, hh); const unsigned tok = ROWS[32 * w + qi] & 0xfffffu;
            const float ao = wsf[qi], a0 = wsf[32 + qi], a1 = wsf[64 + qi], a2 = wsf[96 + qi];
            const size_t off = (size_t)tok * DM + h * HD + c;
#pragma unroll
            for (int dg = 0; dg < 4; ++dg) {
                float v = o[dg][i] * ao;
                if (0 < nr) v += a0 * bf1(P0[off + 32 * dg]);
                if (1 < nr) v += a1 * bf1(P1[off + 32 * dg]);
                if (2 < nr) v += a2 * bf1(P2[off + 32 * dg]);
                Q[off + 32 * dg] = (bf16_t)f2bf(v);
            }
        }
    }
}

__device__ __forceinline__ void p6_attn_sel(const Frame& F) {
    const int* CNT = (const int*)(F.ws + WS_CNT); const bf16_t* LIST = (const bf16_t*)(F.ws + WS_LIST);
    int* pre = (int*)(F.lds + AT_MISC);
    int* wt = pre + 1032;
    int* c32 = pre + 1048;
    unsigned* ROWS = (unsigned*)(F.lds + AT_ROWS);
    int t0, t1;
    { int R0 = 0, R1 = 0; const int b0 = 2 * F.tid, b1 = b0 + 1;
      for (int j = (b0 & 31) + 1; j < 32; ++j) R0 += CNT[b0 * 32 + j];
      for (int j = (b1 & 31) + 1; j < 32; ++j) R1 += CNT[b1 * 32 + j];
      t0 = (R0 + 255) >> 8; t1 = (R1 + 255) >> 8; }
    int s = t0 + t1, incl = s;
#pragma unroll
    for (int o = 1; o < 64; o <<= 1) { const int v = __shfl_up(incl, o); if (F.lane >= o) incl += v; }
    if (F.lane == 63) wt[F.wave] = incl;
    __syncthreads();
    int woff = 0;
    for (int ww = 0; ww < F.wave; ++ww) woff += wt[ww];
    pre[2 * F.tid] = woff + incl - s; pre[2 * F.tid + 1] = woff + incl - s + t0;
    if (F.tid == 511) pre[1024] = woff + incl;
    __syncthreads();
    const int total = pre[1024];
    const int ubeg = (int)((long)F.vcu * total / F.G), uend = (int)((long)(F.vcu + 1) * total / F.G);
    int cur = -1;
    for (int u = ubeg; u < uend; ++u) {
        int lo = 0, hi = 1023;
        while (lo < hi) { const int mid = (lo + hi + 1) >> 1; if (pre[mid] <= u) lo = mid; else hi = mid - 1; }
        const int bk = lo, t = u - pre[bk], bh = bk >> 5, n = bk & 31, b = bh >> 3;
        __syncthreads();
        if (bk != cur) { attn_load_kv(F, bh, n); cur = bk; }
        if (F.tid < 32) c32[F.tid] = (F.tid > n) ? CNT[bk * 32 + F.tid] : 0;
        __syncthreads();
        if (F.tid < 256) {
            const int grow = 256 * t + F.tid; int accn = 0, jj = -1, idx = 0;
            for (int j = n + 1; j < 32; ++j) { const int cj = c32[j]; if (jj < 0 && grow < accn + cj) { jj = j; idx = grow - accn; } accn += cj; }
            unsigned info;
            if (jj >= 0) { const unsigned e = LIST[((size_t)bk * 32 + jj) * 256 + idx]; info = (unsigned)(b * SEQ + jj * 256 + (e & 255u)) | ((e >> 8) << 20) | 0x80000000u; }
            else info = 0xffffffffu;
            ROWS[F.tid] = info;
        }
        __syncthreads();
        if (F.tid < 256 && ROWS[F.tid] == 0xffffffffu) {
            ROWS[F.tid] = ROWS[0] & 0x000fffffu; }
        __syncthreads();
        attn_tile<0>(F, bh, 0);
    }
    __syncthreads();
}
__device__ __forceinline__ void p7_attn_own(const Frame& F) {
    unsigned* ROWS = (unsigned*)(F.lds + AT_ROWS);
    for (int un = F.vcu * 4; un < F.vcu * 4 + 4 && un < NBH * NBLK; ++un) {
        const int bh = un >> 5, j = un & 31, b = bh >> 3;
        __syncthreads();
        attn_load_kv(F, bh, j);
        if (F.tid < 256) ROWS[F.tid] = (unsigned)(b * SEQ + j * 256 + F.tid) | 0x80000000u;
        __syncthreads();
        attn_tile<1>(F, bh, j);
    }
    __syncthreads();
}

__device__ __forceinline__ void p10_norm_mid(const Frame& F, const Args& a) {
    const bf16_t* MIX = (const bf16_t*)(F.ws + WS_SLOT0 + 2 * SLOT_BYTES); bf16_t* U2 = (bf16_t*)(F.ws + WS_SLOT0);
    const float* g2 = a.in[2]; const float* g3 = a.in[14];
    const int gw = F.vcu * NWAVE + F.wave, NGW = F.G * NWAVE;
    for (int m = gw; m < T; m += NGW) {
        const u32x2* mr = (const u32x2*)(MIX + (size_t)m * DM) + F.lane; const f32x4* xr = (const f32x4*)(a.in[0] + (size_t)m * DM) + F.lane;
        f32x4 v[4]; float s = 0.f;
#pragma unroll
        for (int j = 0; j < 4; ++j) { const u32x2 w = mr[64 * j]; v[j] = (f32x4){bflo(w.x), bfhi(w.x), bflo(w.y), bfhi(w.y)}; s += (v[j].x * v[j].x + v[j].y * v[j].y) + (v[j].z * v[j].z + v[j].w * v[j].w); }
        const float rs = 1.0f / sqrtf(wave_sum(s) * (1.0f / DM) + NORM_EPS);
        float s2 = 0.f;
#pragma unroll
        for (int j = 0; j < 4; ++j) { const f32x4 gv = ((const f32x4*)g2)[64 * j + F.lane]; v[j] = xr[64 * j] + v[j] * rs * gv; s2 += (v[j].x * v[j].x + v[j].y * v[j].y) + (v[j].z * v[j].z + v[j].w * v[j].w); }
        f32x4* orow = (f32x4*)(F.out + (size_t)m * DM) + F.lane;
#pragma unroll
        for (int j = 0; j < 4; ++j) orow[64 * j] = v[j];
        const float rs2 = 1.0f / sqrtf(wave_sum(s2) * (1.0f / DM) + NORM_EPS);
        u32x2* o8 = (u32x2*)(U2 + (size_t)m * DM) + F.lane;
#pragma unroll
        for (int j = 0; j < 4; ++j) { const f32x4 gv = ((const f32x4*)g3)[64 * j + F.lane]; u32x2 w; w.x = cvt_pk_bf16(v[j].x * rs2 * gv.x, v[j].y * rs2 * gv.y); w.y = cvt_pk_bf16(v[j].z * rs2 * gv.z, v[j].w * rs2 * gv.w); o8[64 * j] = w; }
    }
}
__device__ __forceinline__ void p13_norm_final(const Frame& F, const Args& a) {
    const bf16_t* MD = (const bf16_t*)(F.ws + WS_SLOT0 + 1 * SLOT_BYTES); const float* g4 = a.in[15];
    const int gw = F.vcu * NWAVE + F.wave, NGW = F.G * NWAVE;
    for (int m = gw; m < T; m += NGW) {
        const u32x2* mr = (const u32x2*)(MD + (size_t)m * DM) + F.lane; f32x4* orow = (f32x4*)(F.out + (size_t)m * DM) + F.lane;
        f32x4 v[4]; float s = 0.f;
#pragma unroll
        for (int j = 0; j < 4; ++j) { const u32x2 w = mr[64 * j]; v[j] = (f32x4){bflo(w.x), bfhi(w.x), bflo(w.y), bfhi(w.y)}; s += (v[j].x * v[j].x + v[j].y * v[j].y) + (v[j].z * v[j].z + v[j].w * v[j].w); }
        const float rs = 1.0f / sqrtf(wave_sum(s) * (1.0f / DM) + NORM_EPS);
#pragma unroll
        for (int j = 0; j < 4; ++j) { const f32x4 gv = ((const f32x4*)g4)[64 * j + F.lane]; orow[64 * j] = orow[64 * j] + v[j] * rs * gv; }
    }
}

#define LAS __attribute__((address_space(3)))
#define XB_TMO      128
#define XB_XCNT(j)  (256  + 64 * (j))
#define XB_XSUB(j)  (1280 + 64 * (j))
#define XB_XGEN(j)  (2304 + 64 * (j))
#define XB_TOP      3328
#define XB_TOPGEN   3392
#define XCD_BAR_WORDS 3456
#define XB_SPIN_CAP (1u << 22)
__device__ __forceinline__ unsigned xb_ld(unsigned* p)              { return __hip_atomic_load(p, __ATOMIC_RELAXED, __HIP_MEMORY_SCOPE_AGENT); }
__device__ __forceinline__ unsigned xb_add(unsigned* p, unsigned v) { return __hip_atomic_fetch_add(p, v, __ATOMIC_RELAXED, __HIP_MEMORY_SCOPE_AGENT); }
__device__ __forceinline__ unsigned xb_xcc_id() { return (unsigned)__builtin_amdgcn_s_getreg((3 << 11) | 20) & 0xFu; }
#define XB_SPIN(cond, bar) do { unsigned _sp = 0; while (cond) { __builtin_amdgcn_s_sleep(1); \
    if ((++_sp & 255u) == 0u) { if (xb_ld(&(bar)[XB_TMO])) break; if (_sp > XB_SPIN_CAP) { atomicAdd(&(bar)[XB_TMO], 1u); break; } } } } while (0)
struct XcdBarrier { unsigned* bar; unsigned x; volatile unsigned* st; };
__device__ __forceinline__ XcdBarrier xcd_barrier_post(unsigned* bar, volatile unsigned* st) {
    XcdBarrier b; b.bar = bar; b.x = xb_xcc_id(); b.st = st;
    if (threadIdx.x == 0) (void)xb_add(&bar[XB_XCNT(b.x)], 1u);
    return b;
}
__device__ __forceinline__ void xcd_barrier_complete(unsigned* bar, unsigned x, unsigned& nloc, unsigned& nx) {
    const unsigned G = gridDim.x * gridDim.y * gridDim.z;
    unsigned sum, cnt, mine, sp = 0u;
    for (;;) {
        sum = 0u; cnt = 0u; mine = 0u;
#pragma unroll
        for (unsigned j = 0; j < 16; ++j) { const unsigned c = xb_ld(&bar[XB_XCNT(j)]); sum += c; cnt += (c > 0u) ? 1u : 0u; mine = (j == x) ? c : mine; }
        if (sum == G) break;
        __builtin_amdgcn_s_sleep(1);
        if ((++sp & 255u) == 0u) { if (xb_ld(&bar[XB_TMO])) break; if (sp > XB_SPIN_CAP) { atomicAdd(&bar[XB_TMO], 1u); break; } }
    }
    nloc = mine > 0u ? mine : 1u; nx = cnt > 0u ? cnt : 1u;
}
__device__ __forceinline__ void xcd_barrier(const XcdBarrier& b) {
    asm volatile("s_waitcnt vmcnt(0)" ::: "memory");
    __syncthreads();
    if (threadIdx.x == 0) {
        unsigned* bar = b.bar;
        __builtin_amdgcn_s_waitcnt(0);
        unsigned nloc = b.st[0], nx = b.st[1];
        if (nloc == 0u) { xcd_barrier_complete(bar, b.x, nloc, nx); b.st[0] = nloc; b.st[1] = nx; }
        const unsigned old = xb_add(&bar[XB_XSUB(b.x)], 1u);
        const unsigned gen = old / nloc;
        if (old + 1u == (gen + 1u) * nloc) {
            __builtin_amdgcn_fence(__ATOMIC_RELEASE, "agent");
            asm volatile("s_waitcnt vmcnt(0)" ::: "memory");
            const unsigned og = xb_add(&bar[XB_TOP], 1u);
            const unsigned tg = og / nx;
            if (og + 1u == (tg + 1u) * nx) xb_add(&bar[XB_TOPGEN], 1u);
            else XB_SPIN(xb_ld(&bar[XB_TOPGEN]) == tg, bar);
            __builtin_amdgcn_fence(__ATOMIC_ACQUIRE, "agent");
            xb_add(&bar[XB_XGEN(b.x)], 1u);
            asm volatile("s_waitcnt vmcnt(0)" ::: "memory");
        } else {
            XB_SPIN(xb_ld(&bar[XB_XGEN(b.x)]) == gen, bar);
            __builtin_amdgcn_fence(__ATOMIC_ACQUIRE, "agent");
            asm volatile("s_waitcnt vmcnt(0)" ::: "memory");
        }
    }
    __syncthreads();
}

#define GEMM_BODY gemm_simple

__global__ void __launch_bounds__(NTHR, 2) fwd_kernel(Args args) {
    extern __shared__ __attribute__((aligned(16))) unsigned char lds[];
    Frame F;
    F.lds = lds; F.tid = threadIdx.x; F.lane = F.tid & 63; F.wave = __builtin_amdgcn_readfirstlane(F.tid >> 6);
    F.G = gridDim.x; { const int bx = blockIdx.x; F.vcu = (F.G % 8 == 0) ? (bx % 8) * (F.G / 8) + bx / 8 : bx; }
    F.ws = args.ws; F.out = args.out;
    unsigned char* ws = args.ws;
    bf16_t* S0 = (bf16_t*)(ws + WS_SLOT0);
#define SL(i) ((bf16_t*)(ws + WS_SLOT0 + (size_t)(i) * SLOT_BYTES))
    const float* cosT = (const float*)(ws + WS_COS); const float* sinT = (const float*)(ws + WS_SIN);
    const int lo = args.ph_lo, hi = args.ph_hi;
    volatile unsigned* bst = (volatile unsigned*)(lds + LDS_BYTES - 64);
    if (F.tid < 16) ((volatile unsigned*)(lds + LDS_BYTES - 64))[F.tid] = 0u;
    __syncthreads();
    XcdBarrier bar; bar.bar = (unsigned*)(ws + WS_CTL) + 1024; bar.x = 0; bar.st = bst;
    if (hi - lo > 1) bar = xcd_barrier_post((unsigned*)(ws + WS_CTL) + 1024, bst);
#define IN(k) (lo <= (k) && (k) < hi)
#define SEAM(k) do { if ((k) + 1 < hi) xcd_barrier(bar); } while (0)

    if (IN(0)) { p0_prologue(F, args); SEAM(0); }
    if (IN(1)) {
        { Gemm g{(const bf16_t*)args.out, nullptr, (const bf16_t*)(ws + WS_WIN), nullptr, DM, DM, DM, 0, 0};
          StaticOrder S; S.init(T, 6144, F.G, (int)blockIdx.x, 0);
          EpiStore<0, true, true> E{S0, DM, cosT, sinT};
          GEMM_BODY(F.lds, g, S, E); }
        { Gemm g{(const bf16_t*)(ws + WS_WIN) + (size_t)6144 * DM, nullptr, (const bf16_t*)args.out, nullptr, DM, DM, DM, 0, 0};
          StaticOrder S; S.init(DM, T, F.G, (int)blockIdx.x, 0);
          EpiStore<0, false, false> E{SL(2), T, nullptr, nullptr};
          GEMM_BODY(F.lds, g, S, E); }
        SEAM(1);
    }
    if (IN(2)) { p2_conv_kmean(F, args); SEAM(2); }
    if (IN(3)) {
        { Gemm g{(const bf16_t*)args.out, nullptr, (const bf16_t*)(ws + WS_WRG), nullptr, DM, 256, 256, 1, 256};
          StaticOrder S; S.init(T, 2048, F.G, (int)blockIdx.x, 0);
          EpiRG E{(const bf16_t*)args.out, (bf16_t*)((unsigned char*)args.out + SLOT_BYTES), SL(3), args.in[7], args.in[9], (const float*)(ws + WS_C8)};
          GEMM_BODY(F.lds, g, S, E); }
        p3_select(F);
        SEAM(3);
    }
    if (IN(4)) { p45_scan<1>(F); SEAM(4); }
    if (IN(5)) { p45_scan<2>(F); SEAM(5); }
    if (IN(6)) { p6_attn_sel(F); SEAM(6); }
    if (IN(7)) { p7_attn_own(F); SEAM(7); }
    if (IN(8)) {
        Gemm g{SL(0), SL(4), (const bf16_t*)(ws + WS_WBA), (const bf16_t*)(ws + WS_WBL), DM, DM, DM, 0, 0};
        StaticOrder S; S.init(T, DM, F.G, (int)blockIdx.x, 1);
        EpiBranch E{SL(5), SL(6), SL(1)};
        GEMM_BODY(F.lds, g, S, E);
        SEAM(8);
    }
    if (IN(9)) {
        Gemm g{SL(1), nullptr, (const bf16_t*)(ws + WS_WOUT), nullptr, DM, DM, DM, 0, 0};
        StaticOrder S; S.init(T, DM, F.G, (int)blockIdx.x, 0);
        EpiStore<0, false, false> E{SL(2), DM, nullptr, nullptr};
        GEMM_BODY(F.lds, g, S, E);
        SEAM(9);
    }
    if (IN(10)) { p10_norm_mid(F, args); SEAM(10); }
    if (IN(11)) {
        Gemm g{SL(0), nullptr, (const bf16_t*)(ws + WS_WUP), nullptr, DM, DM, DM, 0, 0};
        StaticOrder S; S.init(T, FF, F.G, (int)blockIdx.x, 0);
        EpiStore<1, false, false> E{SL(3), FF, nullptr, nullptr};
        GEMM_BODY(F.lds, g, S, E);
        SEAM(11);
    }
    if (IN(12)) {
        Gemm g{SL(3), nullptr, (const bf16_t*)(ws + WS_WDN), nullptr, FF, FF, FF, 0, 0};
        StaticOrder S; S.init(T, DM, F.G, (int)blockIdx.x, 0);
        EpiStore<0, false, false> E{SL(1), DM, nullptr, nullptr};
        GEMM_BODY(F.lds, g, S, E);
        SEAM(12);
    }
    if (IN(13)) { p13_norm_final(F, args); }
}

extern "C" void kernel_launch(void* const* d_in, const int* in_sizes, int n_in, void* d_out, int out_size, void* d_ws, size_t ws_size, hipStream_t stream) {
    static int grid = 0;
    if (grid == 0) {
        if (n_in != 18 || out_size != T * DM || ws_size < WS_END) { fprintf(stderr, "kernel_launch: unexpected shapes (n_in %d out %d ws %zu)\n", n_in, out_size, ws_size); grid = -1; return; }
        int dev = 0, cus = 0;
        if (hipGetDevice(&dev) != hipSuccess || hipDeviceGetAttribute(&cus, hipDeviceAttributeMultiprocessorCount, dev) != hipSuccess) { grid = -1; return; }
        if (hipFuncSetAttribute((const void*)fwd_kernel, hipFuncAttributeMaxDynamicSharedMemorySize, LDS_BYTES) != hipSuccess) { fprintf(stderr, "kernel_launch: hipFuncSetAttribute failed\n"); grid = -1; return; }
        grid = cus;
    }
    if (grid < 0) return;
    Args a{};
    for (int i = 0; i < 18; ++i) a.in[i] = (const float*)d_in[i];
    a.out = (float*)d_out; a.ws = (unsigned char*)d_ws;
#if N_LAUNCH_MODE == 0
    for (int ph = 0; ph < NPHASE; ++ph) {
        a.ph_lo = ph; a.ph_hi = ph + 1;
        hipLaunchKernelGGL(fwd_kernel, dim3(grid), dim3(NTHR), LDS_BYTES, stream, a);
    }
#else
    (void)hipMemsetAsync((char*)d_ws + WS_CTL, 0, 65536, stream);
    a.ph_lo = 0; a.ph_hi = NPHASE;
    hipLaunchKernelGGL(fwd_kernel, dim3(grid), dim3(NTHR), LDS_BYTES, stream, a);
#endif
}
```

```cpp
#include <hip/hip_runtime.h>
#include <cstdio>
#include <cstdint>

#ifndef N_LAUNCH_MODE
#define N_LAUNCH_MODE 1
#endif

typedef unsigned short bf16_t;
typedef short bf16x8 __attribute__((ext_vector_type(8)));
typedef short bf16x4 __attribute__((ext_vector_type(4)));
typedef float f32x4 __attribute__((ext_vector_type(4)));
typedef float f32x16 __attribute__((ext_vector_type(16)));
typedef unsigned u32x4 __attribute__((ext_vector_type(4)));
typedef unsigned u32x2 __attribute__((ext_vector_type(2)));
#define LAS __attribute__((address_space(3)))

constexpr int BATCH = 4, SEQ = 8192, DM = 1024, NH = 8, HD = 128, FF = 4096;
constexpr int T = BATCH * SEQ;
constexpr int NBLK = SEQ / 256;
constexpr int NBH = BATCH * NH;
constexpr int NTHR = 512, NWAVE = 8;
constexpr int LDS_BYTES = 147456;
constexpr float NORM_EPS = 1e-6f;
constexpr int NPHASE = 14;

constexpr size_t MiB = 1u << 20;
constexpr size_t WS_CTL = 0;
constexpr size_t WS_WIN = 1 * MiB;
constexpr size_t WS_WRG = 15 * MiB;
constexpr size_t WS_WBA = 16 * MiB, WS_WBL = 18 * MiB, WS_WOUT = 20 * MiB;
constexpr size_t WS_WUP = 22 * MiB;
constexpr size_t WS_WDN = 30 * MiB;
constexpr size_t WS_SLOT0 = 40 * MiB, SLOT_BYTES = 64 * MiB;
constexpr size_t SLOT_ELEMS = SLOT_BYTES / 2;
constexpr size_t WS_TAIL = 488 * MiB;
constexpr size_t WS_COS = WS_TAIL, WS_SIN = WS_TAIL + 512 * 1024;
constexpr size_t WS_KM = WS_TAIL + 1 * MiB;
constexpr size_t WS_CNT = WS_TAIL + 1 * MiB + 512 * 1024;
constexpr size_t WS_SUMLA = WS_TAIL + 2 * MiB, WS_SUMH = WS_TAIL + 3 * MiB;
constexpr size_t WS_LSE = WS_TAIL + 4 * MiB;
constexpr size_t WS_LIST = WS_TAIL + 7 * MiB;
constexpr size_t WS_C8 = WS_TAIL + 23 * MiB;
constexpr size_t WS_END = 512 * MiB;


struct Args { const float* in[18]; float* out; unsigned char* ws; int ph_lo, ph_hi; };

__device__ __forceinline__ unsigned cvt_pk_bf16(float lo, float hi) { unsigned r; asm volatile("v_cvt_pk_bf16_f32 %0, %1, %2" : "=v"(r) : "v"(lo), "v"(hi)); return r; }
__device__ __forceinline__ float bflo(unsigned w) { return __uint_as_float(w << 16); }
__device__ __forceinline__ float bfhi(unsigned w) { return __uint_as_float(w & 0xffff0000u); }
__device__ __forceinline__ float bf1(bf16_t u) { return __uint_as_float((unsigned)u << 16); }
__device__ __forceinline__ float sigmoidf_(float x) { return __builtin_amdgcn_rcpf(1.0f + __expf(-x)); }
__device__ __forceinline__ float gelu_tanh(float x) {
    const float z = 0.7978845608028654f * (x + 0.044715f * x * x * x);
    return x * sigmoidf_(2.0f * z);
}
__device__ __forceinline__ float wave_sum(float v) {
#pragma unroll
    for (int o = 1; o < 64; o <<= 1) v += __shfl_xor(v, o);
    return v;
}
__device__ __forceinline__ int crow(int r, int hi) { return (r & 3) + 8 * (r >> 2) + 4 * hi; }

struct Frame {
    unsigned char* lds; int tid, lane, wave, vcu, G;
    unsigned char* ws; float* out;
};
__device__ __forceinline__ void refresh(Frame& F) { int t = threadIdx.x; asm volatile("" : "+v"(t)); F.tid = t; F.lane = t & 63; F.wave = __builtin_amdgcn_readfirstlane(t >> 6); }

__host__ __device__ __forceinline__ int perm32(int rho) { const int n = rho >> 4, i = rho & 15; return 8 * (i >> 2) + 4 * n + (i & 3); }
struct Unit { int pm, pn, seg; };
struct Gemm { const bf16_t* A0; const bf16_t* A1; const bf16_t* B0; const bf16_t* B1; int lda, ldb, K, a_grp_shift, a_grp_stride; };

constexpr int NXCD = 8, WGM = 8;
struct StaticOrder {
    int nM, nN, nwg, G, c, dual;
    __device__ void init(int M, int N, int G_, int c_, int dual_) { nM = M / 256; nN = N / 256; nwg = nM * nN; G = G_; c = c_; dual = dual_; }
    __device__ bool next(int i, Unit& u) const {
        const int ip = dual ? (i >> 1) : i; u.seg = dual ? (i & 1) : 0;
        const long L = (long)ip * G + c; if (L >= nwg) return false;
        int wgid = (int)L; { const int q = nwg / NXCD, r = nwg % NXCD, xcd = wgid % NXCD, off = wgid / NXCD; wgid = (xcd < r ? xcd * (q + 1) : r * (q + 1) + (xcd - r) * q) + off; }
        const int nig = WGM * nN, gid = wgid / nig, fm = gid * WGM, gsz = (nM - fm) < WGM ? (nM - fm) : WGM;
        u.pm = fm + ((wgid % nig) % gsz); u.pn = (wgid % nig) / gsz; return true;
    }
};

template <int LDA_, int LDB_, int KK_, int GSH_, int GST_, bool DUAL_, class Epi, class Sched>
__device__ __forceinline__ void gemm_simple(unsigned char* lds, const Gemm g, const Sched& S, const Epi& E) {
    const int tid = threadIdx.x, wid = __builtin_amdgcn_readfirstlane(tid >> 6), lane = tid & 63, wr = wid >> 2, wc = wid & 3, fr = lane & 15, fq = lane >> 4;
    constexpr int RS = 80;
    unsigned char* As = lds; unsigned char* Bs = lds + 256 * RS;
    const int row = tid >> 2, c4 = tid & 3;
    const int brow = Epi::PERM ? ((row & ~31) + perm32(row & 31)) : row;
    Unit u;
    for (int ui = 0; S.next(ui, u); ++ui) {
        f32x4 acc[2][2][4][2];
#pragma unroll
        for (int a = 0; a < 2; ++a)
#pragma unroll
            for (int b = 0; b < 2; ++b)
#pragma unroll
                for (int m = 0; m < 4; ++m)
#pragma unroll
                    for (int n = 0; n < 2; ++n) acc[a][b][m][n] = (f32x4){0.f, 0.f, 0.f, 0.f};
        const bf16_t* A = (u.seg ? g.A1 : g.A0) + (size_t)u.pm * 256 * g.lda + (size_t)(u.pn >> g.a_grp_shift) * g.a_grp_stride + (size_t)row * g.lda + c4 * 8;
        const bf16_t* Bt = (u.seg ? g.B1 : g.B0) + (size_t)u.pn * 256 * g.ldb + (size_t)brow * g.ldb + c4 * 8;
        const size_t a128 = (size_t)128 * g.lda, b128 = (size_t)128 * g.ldb;
        for (int k0 = 0; k0 < g.K; k0 += 32) {
            const u32x4 va0 = *(const u32x4*)(A + k0), va1 = *(const u32x4*)(A + a128 + k0);
            const u32x4 vb0 = *(const u32x4*)(Bt + k0), vb1 = *(const u32x4*)(Bt + b128 + k0);
            __syncthreads();
            *(u32x4*)(As + row * RS + c4 * 16) = va0; *(u32x4*)(As + (row + 128) * RS + c4 * 16) = va1;
            *(u32x4*)(Bs + row * RS + c4 * 16) = vb0; *(u32x4*)(Bs + (row + 128) * RS + c4 * 16) = vb1;
            __syncthreads();
            bf16x8 Bf[2][2];
#pragma unroll
            for (int bj = 0; bj < 2; ++bj)
#pragma unroll
                for (int n = 0; n < 2; ++n) Bf[bj][n] = *(const bf16x8*)(Bs + (128 * bj + 32 * wc + 16 * n + fr) * RS + fq * 16);
#pragma unroll
            for (int ai = 0; ai < 2; ++ai) {
                bf16x8 Af[4];
#pragma unroll
                for (int m = 0; m < 4; ++m) Af[m] = *(const bf16x8*)(As + (128 * ai + 64 * wr + 16 * m + fr) * RS + fq * 16);
#pragma unroll
                for (int bj = 0; bj < 2; ++bj)
#pragma unroll
                    for (int m = 0; m < 4; ++m)
#pragma unroll
                        for (int n = 0; n < 2; ++n) acc[ai][bj][m][n] = __builtin_amdgcn_mfma_f32_16x16x32_bf16(Bf[bj][n], Af[m], acc[ai][bj][m][n], 0, 0, 0);
            }
        }
        asm volatile("" ::: "memory");
        E(acc, u, wr, wc, fr, fq);
    }
    __syncthreads();
}


namespace pg8 {
constexpr int BM = 256, BK = 64, HALF = 128, HTB = HALF * BK * 2, STAGE_BYTES = 8 * HTB;
__host__ __device__ __forceinline__ int lds_byte(int r, int c) { const int st = (r >> 4) * 2 + (c >> 5), rr = r & 15, cc = c & 31, ob = rr * 64 + cc * 2; return st * 1024 + (ob ^ (((ob >> 9) & 1) << 5)); }
__host__ __device__ __forceinline__ void stage_rc(int b, int& R, int& C) { const int st = b / 1024, sb = b % 1024, swz = sb ^ (((sb >> 9) & 1) << 5); R = (st >> 1) * 16 + swz / 64; C = (st & 1) * 32 + (swz % 64) / 2; }

template <class Epi, class Sched, int LDA, int LDB, int KK, int GSH, int GST, bool DUAL>
__device__ __forceinline__ void gemm_phase(LAS unsigned char* lds, const Gemm g, const Sched& S, const Epi& E) {
    int tid = threadIdx.x; asm volatile("" : "+v"(tid));
    const int wid = __builtin_amdgcn_readfirstlane(tid >> 6), lane = tid & 63, wr = wid >> 2, wc = wid & 3, fr = lane & 15, fq = lane >> 4;
    constexpr int K = KK, nt = K / BK;
    const __amdgpu_buffer_rsrc_t rA0 = __builtin_amdgcn_make_buffer_rsrc((void*)g.A0, 0, 0x7ffffffe, 0x00020000);
    const __amdgpu_buffer_rsrc_t rB0 = __builtin_amdgcn_make_buffer_rsrc((void*)g.B0, 0, 0x7ffffffe, 0x00020000);
    const __amdgpu_buffer_rsrc_t rA1 = __builtin_amdgcn_make_buffer_rsrc((void*)(DUAL ? g.A1 : g.A0), 0, 0x7ffffffe, 0x00020000);
    const __amdgpu_buffer_rsrc_t rB1 = __builtin_amdgcn_make_buffer_rsrc((void*)(DUAL ? g.B1 : g.B0), 0, 0x7ffffffe, 0x00020000);
    int voffA[2], voffB[2];
#pragma unroll
    for (int i = 0; i < 2; ++i) { int R, C; stage_rc(tid * 16 + i * 8192, R, C); const int Rb = Epi::PERM ? ((R & ~31) + perm32(R & 31)) : R;
        voffA[i] = (R * LDA + C) * 2; voffB[i] = (Rb * LDB + C) * 2; }
    constexpr int kstep = BK * 2;
    constexpr int hstepA = HALF * LDA * 2, hstepB = HALF * LDB * 2;
    const unsigned ldsw = (unsigned)wid * 1024u;
    const int aoff = lds_byte(wr * 64 + fr, fq * 8), boff = lds_byte(wc * 32 + fr, fq * 8);
#define PG8_UA(u) (((u).pm * 256 * LDA + ((u).pn >> GSH) * GST) * 2)
#define PG8_UB(u) ((u).pn * 256 * LDB * 2)
#define PG8_SA(b, h) (((b) * 2 + (h)) * HTB)
#define PG8_SB(b, h) ((4 + (b) * 2 + (h)) * HTB)
#define PG8_STAGE_A(bufoff, sg, soff) do { _Pragma("unroll") for (int _i = 0; _i < 2; ++_i) \
        __builtin_amdgcn_raw_ptr_buffer_load_lds((DUAL && (sg)) ? rA1 : rA0, (LAS unsigned*)(lds + (bufoff) + ldsw + _i * 8192), 16, voffA[_i], (soff), 0, 0); } while (0)
#define PG8_STAGE_B(bufoff, sg, soff) do { _Pragma("unroll") for (int _i = 0; _i < 2; ++_i) \
        __builtin_amdgcn_raw_ptr_buffer_load_lds((DUAL && (sg)) ? rB1 : rB0, (LAS unsigned*)(lds + (bufoff) + ldsw + _i * 8192), 16, voffB[_i], (soff), 0, 0); } while (0)
#define PG8_LDA(dst, b, h) do { _Pragma("unroll") for (int m = 0; m < 4; ++m) _Pragma("unroll") for (int k = 0; k < 2; ++k) dst[m][k] = *(const LAS bf16x8*)(lds + PG8_SA(b, h) + aoff + m * 2048 + k * 1024); } while (0)
#define PG8_LDB(dst, b, h) do { _Pragma("unroll") for (int n = 0; n < 2; ++n) _Pragma("unroll") for (int k = 0; k < 2; ++k) dst[n][k] = *(const LAS bf16x8*)(lds + PG8_SB(b, h) + boff + n * 2048 + k * 1024); } while (0)
#define PG8_MMA(ai, bj, At, Bt) do { __builtin_amdgcn_s_setprio(1); _Pragma("unroll") for (int m = 0; m < 4; ++m) _Pragma("unroll") for (int n = 0; n < 2; ++n) _Pragma("unroll") for (int k = 0; k < 2; ++k) \
        acc[ai][bj][m][n] = __builtin_amdgcn_mfma_f32_16x16x32_bf16(Bt[n][k], At[m][k], acc[ai][bj][m][n], 0, 0, 0); __builtin_amdgcn_s_setprio(0); } while (0)
#define PG8_WAIT_V(n) asm volatile("s_waitcnt vmcnt(" #n ")" ::: "memory")
#define PG8_WAIT_L(n) asm volatile("s_waitcnt lgkmcnt(" #n ")" ::: "memory")
#define PG8_BAR __builtin_amdgcn_s_barrier()
#define PG8_SCHED __builtin_amdgcn_sched_barrier(0)
    Unit cur, nxt; int ui = 0;
    if (!S.next(0, cur)) return;
    f32x4 acc[2][2][4][2];
#pragma unroll
    for (int a = 0; a < 2; ++a)
#pragma unroll
        for (int b = 0; b < 2; ++b)
#pragma unroll
            for (int m = 0; m < 4; ++m)
#pragma unroll
                for (int n = 0; n < 2; ++n) acc[a][b][m][n] = (f32x4){0.f, 0.f, 0.f, 0.f};
    bf16x8 At[4][2], B0[2][2], B1[2][2];
    int cA = PG8_UA(cur), cB = PG8_UB(cur), cs = cur.seg;
    PG8_STAGE_B(PG8_SB(0, 0), cs, cB); PG8_STAGE_B(PG8_SB(0, 1), cs, cB + hstepB); PG8_STAGE_A(PG8_SA(0, 0), cs, cA); PG8_STAGE_A(PG8_SA(0, 1), cs, cA + hstepA);
    if (wr == 1) PG8_BAR;
    PG8_WAIT_V(2); PG8_BAR;
    PG8_STAGE_B(PG8_SB(1, 0), cs, cB + kstep); PG8_STAGE_A(PG8_SA(1, 0), cs, cA + kstep); PG8_STAGE_B(PG8_SB(1, 1), cs, cB + hstepB + kstep);
    PG8_WAIT_V(6); PG8_BAR;
    for (;;) {
        const bool has_next = S.next(ui + 1, nxt);
        const int nA = has_next ? PG8_UA(nxt) : cA, nB = has_next ? PG8_UB(nxt) : cB, ns = has_next ? nxt.seg : cs;
        for (int t = 0; t < nt; t += 2) {
            const bool last = (t == nt - 2);
            const int a1 = cA + (t + 1) * kstep;
            const int a2 = last ? nA : cA + (t + 2) * kstep, b2 = last ? nB : cB + (t + 2) * kstep, s2 = last ? ns : cs;
            const int a3 = a2 + kstep, b3 = b2 + kstep;
            PG8_LDB(B0, 0, 0); PG8_LDB(B1, 0, 1); PG8_SCHED; PG8_LDA(At, 0, 0); PG8_STAGE_A(PG8_SA(1, 1), cs, a1 + hstepA);
            PG8_WAIT_V(8); PG8_WAIT_L(0); PG8_BAR; PG8_MMA(0, 0, At, B0); PG8_MMA(0, 1, At, B1); PG8_BAR; PG8_SCHED;
            PG8_LDA(At, 0, 1); PG8_STAGE_B(PG8_SB(0, 0), s2, b2); PG8_STAGE_B(PG8_SB(0, 1), s2, b2 + hstepB); PG8_STAGE_A(PG8_SA(0, 0), s2, a2);
            PG8_WAIT_V(8); PG8_WAIT_L(0); PG8_BAR; PG8_MMA(1, 0, At, B0); PG8_MMA(1, 1, At, B1); PG8_BAR; PG8_SCHED;
            PG8_LDB(B0, 1, 0); PG8_LDB(B1, 1, 1); PG8_SCHED; PG8_LDA(At, 1, 0); PG8_STAGE_A(PG8_SA(0, 1), s2, a2 + hstepA);
            PG8_WAIT_V(8); PG8_WAIT_L(0); PG8_BAR; PG8_MMA(0, 0, At, B0); PG8_MMA(0, 1, At, B1); PG8_BAR; PG8_SCHED;
            PG8_LDA(At, 1, 1); PG8_STAGE_B(PG8_SB(1, 0), s2, b3); PG8_STAGE_B(PG8_SB(1, 1), s2, b3 + hstepB); PG8_STAGE_A(PG8_SA(1, 0), s2, a3);
            PG8_WAIT_V(8); PG8_WAIT_L(0); PG8_BAR; PG8_MMA(1, 0, At, B0); PG8_MMA(1, 1, At, B1); PG8_BAR; PG8_SCHED;
        }
        if (wr == 0) PG8_BAR;
        asm volatile("" ::: "memory");
        E(acc, cur, wr, wc, fr, fq);
        if (!has_next) break;
#pragma unroll
        for (int a = 0; a < 2; ++a)
#pragma unroll
            for (int b = 0; b < 2; ++b)
#pragma unroll
                for (int m = 0; m < 4; ++m)
#pragma unroll
                    for (int n = 0; n < 2; ++n) acc[a][b][m][n] = (f32x4){0.f, 0.f, 0.f, 0.f};
        cur = nxt; cA = nA; cB = nB; cs = ns; ++ui;
        if (wr == 1) PG8_BAR;
    }
    PG8_WAIT_V(0);
    PG8_BAR;
#undef PG8_UA
#undef PG8_UB
#undef PG8_SA
#undef PG8_SB
#undef PG8_STAGE_A
#undef PG8_STAGE_B
#undef PG8_LDA
#undef PG8_LDB
#undef PG8_MMA
#undef PG8_WAIT_V
#undef PG8_WAIT_L
#undef PG8_BAR
#undef PG8_SCHED
}
}
template <int LDA, int LDB, int KK, int GSH, int GST, bool DUAL, class Epi, class Sched>
__device__ __forceinline__ void gemm_fast(unsigned char* lds, const Gemm g, const Sched& S, const Epi& E) { pg8::gemm_phase<Epi, Sched, LDA, LDB, KK, GSH, GST, DUAL>((LAS unsigned char*)lds, g, S, E); }

template <int ACT, bool SPLIT, bool ROPE> struct EpiStore {
    static constexpr bool PERM = true;
    bf16_t* O; int ldc; const float* cosT; const float* sinT;
    __device__ __forceinline__ void operator()(const f32x4 (&acc)[2][2][4][2], const Unit& u, int wr, int wc, int fr, int fq) const {
        const int row0 = u.pm * 256 + wr * 64 + fr; int colt = u.pn * 256; bf16_t* base = O;
        if (SPLIT) { const int sidx = u.pn >> 2; const int slot = sidx + (sidx >= 2 ? 1 : 0); base = O + (size_t)slot * SLOT_ELEMS; colt = (u.pn & 3) * 256; }
        const int col0 = colt + wc * 32 + 8 * fq;
        const bool rope = ROPE && (u.pn < 8) && (wc == 0);
#pragma unroll
        for (int ai = 0; ai < 2; ++ai)
#pragma unroll
            for (int m = 0; m < 4; ++m) {
                const int row = row0 + ai * 128 + m * 16; bf16_t* rowp = base + (size_t)row * ldc + col0;
                f32x4 c0, c1, s0, s1;
                if (rope) { const int pos = row & (SEQ - 1); const float* cp = cosT + pos * 16 + 8 * (fq & 1); const float* sp = sinT + pos * 16 + 8 * (fq & 1);
                    c0 = *(const f32x4*)cp; c1 = *(const f32x4*)(cp + 4); s0 = *(const f32x4*)sp; s1 = *(const f32x4*)(sp + 4); }
#pragma unroll
                for (int bj = 0; bj < 2; ++bj) {
                    f32x4 v0 = acc[ai][bj][m][0], v1 = acc[ai][bj][m][1];
                    if (rope) {
                        f32x4 p0, p1;
#pragma unroll
                        for (int j = 0; j < 4; ++j) { p0[j] = __shfl_xor(v0[j], 32); p1[j] = __shfl_xor(v1[j], 32); }
                        if (fq < 2) { v0 = v0 * c0 - p0 * s0; v1 = v1 * c1 - p1 * s1; }
                        else        { v0 = v0 * c0 + p0 * s0; v1 = v1 * c1 + p1 * s1; }
                    }
                    if (ACT == 1) {
#pragma unroll
                        for (int j = 0; j < 4; ++j) { const float a = fmaxf(v0[j], 0.f), b = fmaxf(v1[j], 0.f); v0[j] = a * a; v1[j] = b * b; }
                    }
                    u32x4 w; w.x = cvt_pk_bf16(v0[0], v0[1]); w.y = cvt_pk_bf16(v0[2], v0[3]); w.z = cvt_pk_bf16(v1[0], v1[1]); w.w = cvt_pk_bf16(v1[2], v1[3]);
                    *(u32x4*)(rowp + bj * 128) = w;
                }
            }
    }
};

struct EpiRG {
    static constexpr bool PERM = true;
    const bf16_t* XC; bf16_t* LA; bf16_t* BX; const float* ba; const float* bi; const float* c8;
    __device__ __forceinline__ void operator()(const f32x4 (&acc)[2][2][4][2], const Unit& u, int wr, int wc, int fr, int fq) const {
        const int row0 = u.pm * 256 + wr * 64 + fr;
        const int chb = (u.pn >> 1) * 256 + (u.pn & 1) * 128 + wc * 32 + 8 * fq;
#pragma unroll
        for (int n = 0; n < 2; ++n) {
            const int ch0 = chb + 4 * n;
            const f32x4 vba = *(const f32x4*)(ba + ch0), vbi = *(const f32x4*)(bi + ch0), vc8 = *(const f32x4*)(c8 + ch0);
#pragma unroll
            for (int ai = 0; ai < 2; ++ai)
#pragma unroll
                for (int m = 0; m < 4; ++m) {
                    const int row = row0 + ai * 128 + m * 16; const size_t off = (size_t)row * DM + ch0;
                    const u32x2 xw = *(const u32x2*)(XC + off);
                    const float xc[4] = {bflo(xw.x), bfhi(xw.x), bflo(xw.y), bfhi(xw.y)};
                    float la[4], bx[4];
#pragma unroll
                    for (int e = 0; e < 4; ++e) {
                        const float rp = acc[ai][0][m][n][e] + vba[e], ip = acc[ai][1][m][n][e] + vbi[e];
                        const float r = sigmoidf_(rp), ig = sigmoidf_(ip);
                        const float l = vc8[e] * r;
                        const float x2 = 2.0f * l;
                        const float om = (x2 > -0.02f) ? -x2 * (1.0f + x2 * (0.5f + x2 * (1.0f / 6.0f))) : (1.0f - __expf(x2));
                        la[e] = l; bx[e] = __builtin_amdgcn_sqrtf(om) * ig * xc[e];
                    }
                    u32x2 w; w.x = cvt_pk_bf16(la[0], la[1]); w.y = cvt_pk_bf16(la[2], la[3]);
                    *(u32x2*)(LA + off) = w;
                    w.x = cvt_pk_bf16(bx[0], bx[1]); w.y = cvt_pk_bf16(bx[2], bx[3]);
                    *(u32x2*)(BX + off) = w;
                    if (m & 1) asm volatile("" ::: "memory");
                }
        }
    }
};

struct EpiBranch {
    static constexpr bool PERM = true;
    const bf16_t* GA; const bf16_t* GL; bf16_t* MG;
    __device__ __forceinline__ void operator()(const f32x4 (&acc)[2][2][4][2], const Unit& u, int wr, int wc, int fr, int fq) const {
        const int row0 = u.pm * 256 + wr * 64 + fr, col0 = u.pn * 256 + wc * 32 + 8 * fq;
        const bf16_t* gate = u.seg ? GL : GA;
#pragma unroll
        for (int ai = 0; ai < 2; ++ai)
#pragma unroll
            for (int m = 0; m < 4; ++m)
#pragma unroll
                for (int bj = 0; bj < 2; ++bj) {
                    const size_t off = (size_t)(row0 + ai * 128 + m * 16) * DM + col0 + bj * 128;
                    const u32x4 gw = *(const u32x4*)(gate + off);
                    const float gv[8] = {bflo(gw.x), bfhi(gw.x), bflo(gw.y), bfhi(gw.y), bflo(gw.z), bfhi(gw.z), bflo(gw.w), bfhi(gw.w)};
                    float pv[8] = {0.f, 0.f, 0.f, 0.f, 0.f, 0.f, 0.f, 0.f};
                    if (u.seg) { const u32x4 pw = *(const u32x4*)(MG + off);
                        pv[0] = bflo(pw.x); pv[1] = bfhi(pw.x); pv[2] = bflo(pw.y); pv[3] = bfhi(pw.y); pv[4] = bflo(pw.z); pv[5] = bfhi(pw.z); pv[6] = bflo(pw.w); pv[7] = bfhi(pw.w); }
                    float o[8];
#pragma unroll
                    for (int e = 0; e < 8; ++e) o[e] = pv[e] + sigmoidf_(gv[e]) * acc[ai][bj][m][e >> 2][e & 3];
                    u32x4 w; w.x = cvt_pk_bf16(o[0], o[1]); w.y = cvt_pk_bf16(o[2], o[3]); w.z = cvt_pk_bf16(o[4], o[5]); w.w = cvt_pk_bf16(o[6], o[7]);
                    *(u32x4*)(MG + off) = w;
                    asm volatile("" ::: "memory");
                }
    }
};

__device__ __forceinline__ unsigned f2bf(float f) { unsigned u = __float_as_uint(f); return (u + 0x7fffu + ((u >> 16) & 1u)) >> 16; }
__device__ __forceinline__ unsigned pk2(float lo, float hi) { return f2bf(lo) | (f2bf(hi) << 16); }
__device__ __forceinline__ void transpose_item(const float* W, int ldw, int k0, int n0, bf16_t* dst, int Kd, float* scr, int lane) {
#pragma unroll 8
    for (int i = 0; i < 32; ++i) { const int kk = 2 * i + (lane >> 5); scr[kk * 33 + (lane & 31)] = W[(size_t)(k0 + kk) * ldw + n0 + (lane & 31)]; }
    asm volatile("s_waitcnt lgkmcnt(0)" ::: "memory");
    const int c = lane & 7;
#pragma unroll
    for (int j = 0; j < 4; ++j) { const int n = (lane >> 3) + 8 * j; const float* s = scr + (8 * c) * 33 + n;
        u32x4 o; o.x = pk2(s[0 * 33], s[1 * 33]); o.y = pk2(s[2 * 33], s[3 * 33]); o.z = pk2(s[4 * 33], s[5 * 33]); o.w = pk2(s[6 * 33], s[7 * 33]);
        *(u32x4*)(dst + (size_t)n * Kd + k0 + 8 * c) = o; }
    asm volatile("s_waitcnt lgkmcnt(0)" ::: "memory");
}
__device__ __forceinline__ void rms_row_to_bf16(const float* xrow, const float* gain, bf16_t* orow, int lane) {
    const f32x4* xr = (const f32x4*)xrow + lane; const f32x4* gr = (const f32x4*)gain + lane;
    f32x4 v[4]; float s = 0.f;
#pragma unroll
    for (int j = 0; j < 4; ++j) { v[j] = xr[64 * j]; s += (v[j].x * v[j].x + v[j].y * v[j].y) + (v[j].z * v[j].z + v[j].w * v[j].w); }
    const float rs = 1.0f / sqrtf(wave_sum(s) * (1.0f / DM) + NORM_EPS);
    u32x2* o8 = (u32x2*)orow + lane;
#pragma unroll
    for (int j = 0; j < 4; ++j) { const f32x4 gv = gr[64 * j]; u32x2 w; w.x = cvt_pk_bf16(v[j].x * rs * gv.x, v[j].y * rs * gv.y); w.y = cvt_pk_bf16(v[j].z * rs * gv.z, v[j].w * rs * gv.w); o8[64 * j] = w; }
}

__device__ __forceinline__ void p0_prologue(const Frame& F, const Args& a) {
    float* scr = (float*)(F.lds + F.wave * 16384);
    const int gw = F.vcu * NWAVE + F.wave, NGW = F.G * NWAVE;
    bf16_t* WinT = (bf16_t*)(F.ws + WS_WIN); bf16_t* WrgT = (bf16_t*)(F.ws + WS_WRG);
    constexpr int I_IN = 16 * 224, I_RG = 256, I_SQ = 16 * 32, I_UP = 16 * 128, I_DN = 64 * 32;
    constexpr int NITEMS = I_IN + I_RG + 3 * I_SQ + I_UP + I_DN;
    for (int it = gw; it < NITEMS; it += NGW) {
        int r = it;
        if (r < I_IN) { const int kb = r / 224, nb = r % 224, n0 = nb * 32;
            const int drow = (n0 < 2048) ? n0 : (n0 < 3072 ? 6144 + (n0 - 2048) : n0 - 1024);
            transpose_item(a.in[3], 7168, kb * 64, n0, WinT + (size_t)drow * 1024, 1024, scr, F.lane); continue; }
        r -= I_IN;
        if (r < I_RG) { const int which = r >> 7, g = (r >> 5) & 3, q = r & 31, kb = q >> 3, nb = q & 7, n0 = nb * 32;
            const float* W = a.in[which ? 8 : 6] + (size_t)g * 65536;
            const int tile = 2 * g + (n0 >> 7), drow = tile * 256 + which * 128 + (n0 & 127);
            transpose_item(W, 256, kb * 64, n0, WrgT + (size_t)drow * 256, 256, scr, F.lane); continue; }
        r -= I_RG;
        if (r < 3 * I_SQ) { const int w = r / I_SQ, q = r % I_SQ, kb = q >> 5, nb = q & 31;
            const float* W = a.in[w == 0 ? 11 : (w == 1 ? 12 : 13)]; bf16_t* dst = (bf16_t*)(F.ws + (w == 0 ? WS_WBA : (w == 1 ? WS_WBL : WS_WOUT)));
            transpose_item(W, 1024, kb * 64, nb * 32, dst + (size_t)(nb * 32) * 1024, 1024, scr, F.lane); continue; }
        r -= 3 * I_SQ;
        if (r < I_UP) { const int kb = r >> 7, nb = r & 127;
            transpose_item(a.in[16], 4096, kb * 64, nb * 32, (bf16_t*)(F.ws + WS_WUP) + (size_t)(nb * 32) * 1024, 1024, scr, F.lane); continue; }
        r -= I_UP;
        { const int kb = r >> 5, nb = r & 31;
            transpose_item(a.in[17], 1024, kb * 64, nb * 32, (bf16_t*)(F.ws + WS_WDN) + (size_t)(nb * 32) * 4096, 4096, scr, F.lane); }
    }
    bf16_t* U = (bf16_t*)F.out;
    for (int m = gw; m < T; m += NGW) rms_row_to_bf16(a.in[0] + (size_t)m * DM, a.in[1], U + (size_t)m * DM, F.lane);
    const int gt = F.vcu * NTHR + F.tid, NGT = F.G * NTHR;
    float* cosT = (float*)(F.ws + WS_COS); float* sinT = (float*)(F.ws + WS_SIN);
    for (int e = gt; e < SEQ * 16; e += NGT) {
        const int pos = e >> 4, i = e & 15;
        const float inv = powf(500000.0f, -(float)i * (1.0f / 16.0f));
        const float ang = (float)pos * inv;
        double rev = (double)ang * 0.15915494309189535; rev -= rint(rev);
        const float fr = (float)rev;
        cosT[e] = __builtin_amdgcn_cosf(fr); sinT[e] = __builtin_amdgcn_sinf(fr);
    }
    float* c8 = (float*)(F.ws + WS_C8);
    for (int e = gt; e < DM; e += NGT) { const float lam = a.in[10][e]; c8[e] = -8.0f * log1pf(expf(-lam)); }
}

__device__ __forceinline__ void p2_conv_kmean(const Frame& F, const Args& a) {
    const bf16_t* XL = (const bf16_t*)(F.ws + WS_SLOT0 + 3 * SLOT_BYTES); bf16_t* XC = (bf16_t*)F.out;
    const float* cw = a.in[4]; const float* cb = a.in[5];
    {
        const int cg = F.tid & 127, rg = F.tid >> 7, ch = cg * 8;
        float w[4][8], bs[8];
#pragma unroll
        for (int j = 0; j < 4; ++j)
#pragma unroll
            for (int e = 0; e < 8; ++e) w[j][e] = cw[j * DM + ch + e];
#pragma unroll
        for (int e = 0; e < 8; ++e) bs[e] = cb[ch + e];
        for (int un = F.vcu; un < T / 64; un += F.G) {
            const int row0 = un * 64 + rg * 16; const int t0 = row0 & (SEQ - 1);
            u32x4 h0 = {0, 0, 0, 0}, h1 = {0, 0, 0, 0}, h2 = {0, 0, 0, 0};
            if (t0 >= 3) { h0 = *(const u32x4*)(XL + (size_t)(row0 - 3) * DM + ch); h1 = *(const u32x4*)(XL + (size_t)(row0 - 2) * DM + ch); h2 = *(const u32x4*)(XL + (size_t)(row0 - 1) * DM + ch); }
#pragma unroll 4
            for (int r = 0; r < 16; ++r) {
                const u32x4 cur = *(const u32x4*)(XL + (size_t)(row0 + r) * DM + ch);
                const u32x4 p0 = h0, p1 = h1, p2 = h2, p3 = cur;
                float o[8];
#pragma unroll
                for (int q = 0; q < 4; ++q) {
                    o[2 * q]     = bs[2 * q]     + w[0][2 * q] * bflo(p0[q])     + w[1][2 * q] * bflo(p1[q])     + w[2][2 * q] * bflo(p2[q])     + w[3][2 * q] * bflo(p3[q]);
                    o[2 * q + 1] = bs[2 * q + 1] + w[0][2 * q + 1] * bfhi(p0[q]) + w[1][2 * q + 1] * bfhi(p1[q]) + w[2][2 * q + 1] * bfhi(p2[q]) + w[3][2 * q + 1] * bfhi(p3[q]);
                }
                u32x4 ww; ww.x = cvt_pk_bf16(o[0], o[1]); ww.y = cvt_pk_bf16(o[2], o[3]); ww.z = cvt_pk_bf16(o[4], o[5]); ww.w = cvt_pk_bf16(o[6], o[7]);
                *(u32x4*)(XC + (size_t)(row0 + r) * DM + ch) = ww;
                h0 = h1; h1 = h2; h2 = cur;
            }
        }
    }
    {
        const bf16_t* K = (const bf16_t*)(F.ws + WS_SLOT0 + 1 * SLOT_BYTES); float* KM = (float*)(F.ws + WS_KM);
        float* red = (float*)F.lds;
        const int dg = F.tid & 15, rg = F.tid >> 4;
        for (int un = F.vcu; un < NBH * NBLK; un += F.G) {
            const int bh = un >> 5, n = un & 31, b = bh >> 3, h = bh & 7;
            const bf16_t* kp = K + (size_t)(b * SEQ + n * 256 + rg * 8) * DM + h * HD + dg * 8;
            float s[8] = {0.f, 0.f, 0.f, 0.f, 0.f, 0.f, 0.f, 0.f};
#pragma unroll
            for (int r = 0; r < 8; ++r) { const u32x4 kw = *(const u32x4*)(kp + (size_t)r * DM);
                s[0] += bflo(kw.x); s[1] += bfhi(kw.x); s[2] += bflo(kw.y); s[3] += bfhi(kw.y); s[4] += bflo(kw.z); s[5] += bfhi(kw.z); s[6] += bflo(kw.w); s[7] += bfhi(kw.w); }
            __syncthreads();
#pragma unroll
            for (int e = 0; e < 8; ++e) red[rg * 128 + dg * 8 + e] = s[e];
            __syncthreads();
            if (F.tid < 128) { float t = 0.f;
#pragma unroll 8
                for (int r = 0; r < 32; ++r) t += red[r * 128 + F.tid];
                KM[(size_t)un * 128 + F.tid] = t * (1.0f / 256.0f); }
        }
        __syncthreads();
    }
}

__device__ __forceinline__ void top3_insert(float v, int n, float& v0, float& v1, float& v2, int& i0, int& i1, int& i2) {
    const bool g0 = v > v0, g1 = v > v1, g2 = v > v2;
    const float nv2 = g1 ? v1 : (g2 ? v : v2); const int ni2 = g1 ? i1 : (g2 ? n : i2);
    const float nv1 = g0 ? v0 : (g1 ? v : v1); const int ni1 = g0 ? i0 : (g1 ? n : i1);
    const float nv0 = g0 ? v : v0;             const int ni0 = g0 ? n : i0;
    v0 = nv0; v1 = nv1; v2 = nv2; i0 = ni0; i1 = ni1; i2 = ni2;
}
__device__ __forceinline__ void p3_select(const Frame& F) {
    const bf16_t* Q = (const bf16_t*)(F.ws + WS_SLOT0); const float* KM = (const float*)(F.ws + WS_KM);
    int* CNT = (int*)(F.ws + WS_CNT); bf16_t* LIST = (bf16_t*)(F.ws + WS_LIST);
    float* kms = (float*)F.lds;
    int* cnt = (int*)(F.lds + 16384);
    float* xv = (float*)(F.lds + 16384 + 256);
    int* xi = (int*)(F.lds + 16384 + 256 + 3072);
    const int q = F.tid & 255, half = __builtin_amdgcn_readfirstlane(F.tid >> 8);
    for (int un = F.vcu * 4; un < F.vcu * 4 + 4 && un < NBH * NBLK; ++un) {
        const int bh = un >> 5, j = un & 31, b = bh >> 3, h = bh & 7;
        __syncthreads();
        { const f32x4* src = (const f32x4*)(KM + (size_t)bh * 4096); f32x4* dst = (f32x4*)kms; dst[F.tid] = src[F.tid]; dst[F.tid + 512] = src[F.tid + 512]; }
        if (F.tid < 32) cnt[F.tid] = 0;
        __syncthreads();
        const bf16_t* qp = Q + (size_t)(b * SEQ + j * 256 + q) * DM + h * HD;
        float acc[16];
#pragma unroll
        for (int i = 0; i < 16; ++i) acc[i] = 0.f;
        const int nb = half * 16;
        if (nb < j) {
            for (int dc = 0; dc < 16; ++dc) {
                const u32x4 qw = *(const u32x4*)(qp + dc * 8);
                const float qf[8] = {bflo(qw.x), bfhi(qw.x), bflo(qw.y), bfhi(qw.y), bflo(qw.z), bfhi(qw.z), bflo(qw.w), bfhi(qw.w)};
#pragma unroll
                for (int i = 0; i < 16; ++i) {
                    const f32x4 k0 = *(const f32x4*)(kms + (nb + i) * 128 + dc * 8), k1 = *(const f32x4*)(kms + (nb + i) * 128 + dc * 8 + 4);
                    acc[i] += qf[0] * k0.x + qf[1] * k0.y + qf[2] * k0.z + qf[3] * k0.w + qf[4] * k1.x + qf[5] * k1.y + qf[6] * k1.z + qf[7] * k1.w;
                }
            }
        }
        float v0 = -INFINITY, v1 = -INFINITY, v2 = -INFINITY; int i0 = 0, i1 = 0, i2 = 0;
#pragma unroll
        for (int i = 0; i < 16; ++i) { const int n = nb + i; const float v = (n < j) ? acc[i] : -INFINITY; top3_insert(v, n, v0, v1, v2, i0, i1, i2); }
        if (half == 1) { xv[q * 3] = v0; xv[q * 3 + 1] = v1; xv[q * 3 + 2] = v2; xi[q * 3] = i0; xi[q * 3 + 1] = i1; xi[q * 3 + 2] = i2; }
        __syncthreads();
        if (half == 0) {
            top3_insert(xv[q * 3], xi[q * 3], v0, v1, v2, i0, i1, i2);
            top3_insert(xv[q * 3 + 1], xi[q * 3 + 1], v0, v1, v2, i0, i1, i2);
            top3_insert(xv[q * 3 + 2], xi[q * 3 + 2], v0, v1, v2, i0, i1, i2);
            const int nr = j < 3 ? j : 3;
            if (0 < nr) { const int pos = atomicAdd(&cnt[i0], 1); LIST[((size_t)(bh * 32 + i0) * 32 + j) * 256 + pos] = (bf16_t)(q | (0 << 8)); }
            if (1 < nr) { const int pos = atomicAdd(&cnt[i1], 1); LIST[((size_t)(bh * 32 + i1) * 32 + j) * 256 + pos] = (bf16_t)(q | (1 << 8)); }
            if (2 < nr) { const int pos = atomicAdd(&cnt[i2], 1); LIST[((size_t)(bh * 32 + i2) * 32 + j) * 256 + pos] = (bf16_t)(q | (2 << 8)); }
        }
        __syncthreads();
        if (F.tid < 32) CNT[(bh * 32 + F.tid) * 32 + j] = cnt[F.tid];
    }
    __syncthreads();
}

template <int PASS> __device__ __forceinline__ void p45_scan(const Frame& F) {
    const bf16_t* LA = (const bf16_t*)((unsigned char*)F.out + SLOT_BYTES); const bf16_t* BX = (const bf16_t*)(F.ws + WS_SLOT0 + 3 * SLOT_BYTES);
    bf16_t* G = (bf16_t*)(F.ws + WS_SLOT0 + 4 * SLOT_BYTES);
    float* SLA = (float*)(F.ws + WS_SUMLA); float* SH = (float*)(F.ws + WS_SUMH);
    const int ch = F.tid * 2;
    for (int un = F.vcu; un < BATCH * 64; un += F.G) {
        const int b = un >> 6, c = un & 63;
        const size_t base = (size_t)(b * SEQ + c * 128) * DM + ch;
        float h0 = 0.f, h1 = 0.f, sl0 = 0.f, sl1 = 0.f;
        if (PASS == 2) {
            for (int cc = 0; cc < c; ++cc) { const size_t so = (size_t)(b * 64 + cc) * DM + ch;
                const float2 la = *(const float2*)(SLA + so), hh = *(const float2*)(SH + so);
                h0 = __expf(la.x) * h0 + hh.x; h1 = __expf(la.y) * h1 + hh.y; }
        }
#pragma unroll 8
        for (int r = 0; r < 128; ++r) {
            const unsigned lw = *(const unsigned*)(LA + base + (size_t)r * DM), bw = *(const unsigned*)(BX + base + (size_t)r * DM);
            const float l0 = bflo(lw), l1 = bfhi(lw);
            h0 = __expf(l0) * h0 + bflo(bw); h1 = __expf(l1) * h1 + bfhi(bw);
            if (PASS == 1) { sl0 += l0; sl1 += l1; }
            if (PASS == 2) { const unsigned gw = *(const unsigned*)(G + base + (size_t)r * DM);
                *(unsigned*)(G + base + (size_t)r * DM) = cvt_pk_bf16(h0 * gelu_tanh(bflo(gw)), h1 * gelu_tanh(bfhi(gw))); }
        }
        if (PASS == 1) { const size_t so = (size_t)un * DM + ch; *(float2*)(SLA + so) = make_float2(sl0, sl1); *(float2*)(SH + so) = make_float2(h0, h1); }
    }
}

constexpr int AT_KS = 0, AT_KROW = 272;
constexpr int AT_VS = 256 * AT_KROW, AT_VROW = 520;
constexpr int AT_ROWS = AT_VS + 128 * AT_VROW;
constexpr int AT_WSF = AT_ROWS + 1024;
constexpr int AT_MISC = AT_WSF + 4096;
static_assert(AT_MISC + 4096 + 1024 <= LDS_BYTES, "attention LDS map");
constexpr float SM_SCALE = 0.08838834764831845f;
constexpr float SM_C = SM_SCALE * 1.4426950408889634f;

__device__ __forceinline__ void attn_load_kv(const Frame& F, int bh, int n) {
    const int b = bh >> 3, h = bh & 7;
    const bf16_t* K = (const bf16_t*)(F.ws + WS_SLOT0 + 1 * SLOT_BYTES); const bf16_t* VT = (const bf16_t*)(F.ws + WS_SLOT0 + 2 * SLOT_BYTES);
    const size_t tok0 = (size_t)b * SEQ + n * 256;
#pragma unroll
    for (int p = 0; p < 8; ++p) { const int idx = p * 512 + F.tid, row = idx >> 4, c16 = idx & 15;
        const u32x4 v = *(const u32x4*)(K + (tok0 + row) * DM + h * HD + c16 * 8);
        *(u32x4*)(F.lds + AT_KS + row * AT_KROW + c16 * 16) = v; }
#pragma unroll
    for (int p = 0; p < 8; ++p) { const int idx = p * 512 + F.tid, d = idx >> 5, c16 = idx & 31;
        const u32x4 v = *(const u32x4*)(VT + (size_t)(h * HD + d) * T + tok0 + c16 * 8);
        u32x2* dst = (u32x2*)(F.lds + AT_VS + d * AT_VROW + c16 * 16); dst[0] = (u32x2){v.x, v.y}; dst[1] = (u32x2){v.z, v.w}; }
}

template <int MODE> __device__ __forceinline__ void attn_tile(const Frame& F, int bh, int jblk) {
    const int h = bh & 7, w = F.wave, lane = F.lane, c = lane & 31, hh = lane >> 5;
    const unsigned* ROWS = (const unsigned*)(F.lds + AT_ROWS);
    float* wsf = (float*)(F.lds + AT_WSF) + w * 128;
    bf16_t* Q = (bf16_t*)(F.ws + WS_SLOT0);
    float* LSE = (float*)(F.ws + WS_LSE);
    bf16_t* P0 = (bf16_t*)F.out; bf16_t* P1 = (bf16_t*)((unsigned char*)F.out + SLOT_BYTES); bf16_t* P2 = (bf16_t*)(F.ws + WS_SLOT0 + 3 * SLOT_BYTES);
    const unsigned myinfo = ROWS[32 * w + c];
    const unsigned mytok = myinfo & 0xfffffu;
    const int ng = (MODE == 1) ? (w + 1) : 8;
    bf16x8 qf[8];
    { const bf16_t* qp = Q + (size_t)mytok * DM + h * HD + 8 * hh;
#pragma unroll
      for (int s = 0; s < 8; ++s) qf[s] = *(const bf16x8*)(qp + 16 * s); }
    f32x16 o[4];
#pragma unroll
    for (int dg = 0; dg < 4; ++dg) {
#pragma unroll
        for (int i = 0; i < 16; ++i) o[dg][i] = 0.f;
    }
    float mx = -INFINITY, ls = 0.f;
    const int qlim = c - 4 * hh;
    for (int g = 0; g < ng; ++g) {
        f32x16 st;
#pragma unroll
        for (int i = 0; i < 16; ++i) st[i] = 0.f;
        { const unsigned char* kp = F.lds + AT_KS + (32 * g + c) * AT_KROW + 16 * hh;
#pragma unroll
          for (int s = 0; s < 8; ++s) { const bf16x8 kf = *(const bf16x8*)(kp + 32 * s); st = __builtin_amdgcn_mfma_f32_32x32x16_bf16(kf, qf[s], st, 0, 0, 0); } }
        if (MODE == 1 && g == w) {
#pragma unroll
            for (int i = 0; i < 16; ++i) { const int msk = (qlim - ((i & 3) + 8 * (i >> 2))) >> 31;
                st[i] = fminf(st[i], __uint_as_float(0x7f800000u | ((unsigned)msk & 0x80000000u))); }
        }
        float ml = st[0];
#pragma unroll
        for (int i = 1; i < 16; ++i) ml = fmaxf(ml, st[i]);
        ml = fmaxf(ml, __shfl_xor(ml, 32));
        const float mn = fmaxf(mx, ml);
        const float alpha = __builtin_amdgcn_exp2f((mx - mn) * SM_C);
        float p[16], ps = 0.f;
#pragma unroll
        for (int i = 0; i < 16; ++i) { p[i] = __builtin_amdgcn_exp2f((st[i] - mn) * SM_C); ps += p[i]; }
        ls = ls * alpha + ps;
        if (!__all(mn == mx)) {
            if (hh == 0) wsf[c] = alpha;
            asm volatile("s_waitcnt lgkmcnt(0)" ::: "memory");
#pragma unroll
            for (int i = 0; i < 16; ++i) { const float a = wsf[crow(i, hh)];
#pragma unroll
                for (int dg = 0; dg < 4; ++dg) o[dg][i] *= a; }
        }
        mx = mn;
        bf16x8 pf[2];
#pragma unroll
        for (int s2 = 0; s2 < 2; ++s2) { u32x4 pw; pw.x = cvt_pk_bf16(p[8 * s2], p[8 * s2 + 1]); pw.y = cvt_pk_bf16(p[8 * s2 + 2], p[8 * s2 + 3]); pw.z = cvt_pk_bf16(p[8 * s2 + 4], p[8 * s2 + 5]); pw.w = cvt_pk_bf16(p[8 * s2 + 6], p[8 * s2 + 7]);
            pf[s2] = __builtin_bit_cast(bf16x8, pw); }
#pragma unroll
        for (int s2 = 0; s2 < 2; ++s2) {
#pragma unroll
            for (int dg = 0; dg < 4; ++dg) {
                const unsigned char* vp = F.lds + AT_VS + (32 * dg + c) * AT_VROW + (32 * g + 16 * s2 + 4 * hh) * 2;
                const bf16x4 lo = *(const bf16x4*)vp, hi = *(const bf16x4*)(vp + 16);
                const bf16x8 vf = (bf16x8){lo[0], lo[1], lo[2], lo[3], hi[0], hi[1], hi[2], hi[3]};
                o[dg] = __builtin_amdgcn_mfma_f32_32x32x16_bf16(pf[s2], vf, o[dg], 0, 0, 0);
            }
        }
    }
    ls += __shfl_xor(ls, 32);
    const float lse_own = mx * SM_SCALE + __logf(ls);
    if (MODE == 0) {
        if (hh == 0) { wsf[c] = 1.0f / ls; }
        const unsigned rank = (myinfo >> 20) & 3u; const bool valid = (myinfo >> 31) != 0u;
        if (hh == 0 && valid) LSE[((size_t)rank * T + mytok) * NH + h] = lse_own;
        asm volatile("s_waitcnt lgkmcnt(0)" ::: "memory");
#pragma unroll
        for (int i = 0; i < 16; ++i) {
            const int qi = crow(i, hh); const unsigned info = ROWS[32 * w + qi];
            if (info >> 31) { const unsigned tok = info & 0xfffffu, rk = (info >> 20) & 3u; const float li = wsf[qi];
                bf16_t* pp = (rk == 0 ? P0 : (rk == 1 ? P1 : P2)) + (size_t)tok * DM + h * HD + c;
#pragma unroll
                for (int dg = 0; dg < 4; ++dg) pp[32 * dg] = (bf16_t)f2bf(o[dg][i] * li); }
        }
    } else {
        const int nr = jblk < 3 ? jblk : 3;
        if (hh == 0) {
            float l0 = -INFINITY, l1 = -INFINITY, l2 = -INFINITY;
            if (0 < nr) l0 = LSE[((size_t)0 * T + mytok) * NH + h];
            if (1 < nr) l1 = LSE[((size_t)1 * T + mytok) * NH + h];
            if (2 < nr) l2 = LSE[((size_t)2 * T + mytok) * NH + h];
            const float M = fmaxf(fmaxf(lse_own, l0), fmaxf(l1, l2));
            const float wo = __expf(lse_own - M), w0 = __expf(l0 - M), w1 = __expf(l1 - M), w2 = __expf(l2 - M);
            const float inv = 1.0f / (wo + w0 + w1 + w2);
            wsf[c] = wo * inv / ls; wsf[32 + c] = w0 * inv; wsf[64 + c] = w1 * inv; wsf[96 + c] = w2 * inv;
        }
        asm volatile("s_waitcnt lgkmcnt(0)" ::: "memory");
#pragma unroll
        for (int i = 0; i < 16; ++i) {
            const int qi = crow(i, hh); const unsigned tok = ROWS[32 * w + qi] & 0xfffffu;
            const float ao = wsf[qi], a0 = wsf[32 + qi], a1 = wsf[64 + qi], a2 = wsf[96 + qi];
            const size_t off = (size_t)tok * DM + h * HD + c;
#pragma unroll
            for (int dg = 0; dg < 4; ++dg) {
                float v = o[dg][i] * ao;
                if (0 < nr) v += a0 * bf1(P0[off + 32 * dg]);
                if (1 < nr) v += a1 * bf1(P1[off + 32 * dg]);
                if (2 < nr) v += a2 * bf1(P2[off + 32 * dg]);
                Q[off + 32 * dg] = (bf16_t)f2bf(v);
            }
        }
    }
}

__device__ __forceinline__ void p6_attn_sel(const Frame& F) {
    const int* CNT = (const int*)(F.ws + WS_CNT); const bf16_t* LIST = (const bf16_t*)(F.ws + WS_LIST);
    int* pre = (int*)(F.lds + AT_MISC);
    int* wt = pre + 1032;
    int* c32 = pre + 1048;
    unsigned* ROWS = (unsigned*)(F.lds + AT_ROWS);
    int t0, t1;
    { int R0 = 0, R1 = 0; const int b0 = 2 * F.tid, b1 = b0 + 1;
      for (int j = (b0 & 31) + 1; j < 32; ++j) R0 += CNT[b0 * 32 + j];
      for (int j = (b1 & 31) + 1; j < 32; ++j) R1 += CNT[b1 * 32 + j];
      t0 = (R0 + 255) >> 8; t1 = (R1 + 255) >> 8; }
    int s = t0 + t1, incl = s;
#pragma unroll
    for (int o = 1; o < 64; o <<= 1) { const int v = __shfl_up(incl, o); if (F.lane >= o) incl += v; }
    if (F.lane == 63) wt[F.wave] = incl;
    __syncthreads();
    int woff = 0;
    for (int ww = 0; ww < F.wave; ++ww) woff += wt[ww];
    pre[2 * F.tid] = woff + incl - s; pre[2 * F.tid + 1] = woff + incl - s + t0;
    if (F.tid == 511) pre[1024] = woff + incl;
    __syncthreads();
    const int total = pre[1024];
    const int ubeg = (int)((long)F.vcu * total / F.G), uend = (int)((long)(F.vcu + 1) * total / F.G);
    int cur = -1;
    for (int u = ubeg; u < uend; ++u) {
        int lo = 0, hi = 1023;
        while (lo < hi) { const int mid = (lo + hi + 1) >> 1; if (pre[mid] <= u) lo = mid; else hi = mid - 1; }
        const int bk = lo, t = u - pre[bk], bh = bk >> 5, n = bk & 31, b = bh >> 3;
        __syncthreads();
        if (bk != cur) { attn_load_kv(F, bh, n); cur = bk; }
        if (F.tid < 32) c32[F.tid] = (F.tid > n) ? CNT[bk * 32 + F.tid] : 0;
        __syncthreads();
        if (F.tid < 256) {
            const int grow = 256 * t + F.tid; int accn = 0, jj = -1, idx = 0;
            for (int j = n + 1; j < 32; ++j) { const int cj = c32[j]; if (jj < 0 && grow < accn + cj) { jj = j; idx = grow - accn; } accn += cj; }
            unsigned info;
            if (jj >= 0) { const unsigned e = LIST[((size_t)bk * 32 + jj) * 256 + idx]; info = (unsigned)(b * SEQ + jj * 256 + (e & 255u)) | ((e >> 8) << 20) | 0x80000000u; }
            else info = 0xffffffffu;
            ROWS[F.tid] = info;
        }
        __syncthreads();
        if (F.tid < 256 && ROWS[F.tid] == 0xffffffffu) {
            ROWS[F.tid] = ROWS[0] & 0x000fffffu; }
        __syncthreads();
        attn_tile<0>(F, bh, 0);
    }
    __syncthreads();
}
__device__ __forceinline__ void p7_attn_own(const Frame& F) {
    unsigned* ROWS = (unsigned*)(F.lds + AT_ROWS);
    for (int un = F.vcu * 4; un < F.vcu * 4 + 4 && un < NBH * NBLK; ++un) {
        const int bh = un >> 5, j = un & 31, b = bh >> 3;
        __syncthreads();
        attn_load_kv(F, bh, j);
        if (F.tid < 256) ROWS[F.tid] = (unsigned)(b * SEQ + j * 256 + F.tid) | 0x80000000u;
        __syncthreads();
        attn_tile<1>(F, bh, j);
    }
    __syncthreads();
}

__device__ __forceinline__ void p10_norm_mid(const Frame& F, const Args& a) {
    const bf16_t* MIX = (const bf16_t*)(F.ws + WS_SLOT0 + 2 * SLOT_BYTES); bf16_t* U2 = (bf16_t*)(F.ws + WS_SLOT0);
    const float* g2 = a.in[2]; const float* g3 = a.in[14];
    const int gw = F.vcu * NWAVE + F.wave, NGW = F.G * NWAVE;
    for (int m = gw; m < T; m += NGW) {
        const u32x2* mr = (const u32x2*)(MIX + (size_t)m * DM) + F.lane; const f32x4* xr = (const f32x4*)(a.in[0] + (size_t)m * DM) + F.lane;
        f32x4 v[4]; float s = 0.f;
#pragma unroll
        for (int j = 0; j < 4; ++j) { const u32x2 w = mr[64 * j]; v[j] = (f32x4){bflo(w.x), bfhi(w.x), bflo(w.y), bfhi(w.y)}; s += (v[j].x * v[j].x + v[j].y * v[j].y) + (v[j].z * v[j].z + v[j].w * v[j].w); }
        const float rs = 1.0f / sqrtf(wave_sum(s) * (1.0f / DM) + NORM_EPS);
        float s2 = 0.f;
#pragma unroll
        for (int j = 0; j < 4; ++j) { const f32x4 gv = ((const f32x4*)g2)[64 * j + F.lane]; v[j] = xr[64 * j] + v[j] * rs * gv; s2 += (v[j].x * v[j].x + v[j].y * v[j].y) + (v[j].z * v[j].z + v[j].w * v[j].w); }
        f32x4* orow = (f32x4*)(F.out + (size_t)m * DM) + F.lane;
#pragma unroll
        for (int j = 0; j < 4; ++j) orow[64 * j] = v[j];
        const float rs2 = 1.0f / sqrtf(wave_sum(s2) * (1.0f / DM) + NORM_EPS);
        u32x2* o8 = (u32x2*)(U2 + (size_t)m * DM) + F.lane;
#pragma unroll
        for (int j = 0; j < 4; ++j) { const f32x4 gv = ((const f32x4*)g3)[64 * j + F.lane]; u32x2 w; w.x = cvt_pk_bf16(v[j].x * rs2 * gv.x, v[j].y * rs2 * gv.y); w.y = cvt_pk_bf16(v[j].z * rs2 * gv.z, v[j].w * rs2 * gv.w); o8[64 * j] = w; }
    }
}
__device__ __forceinline__ void p13_norm_final(const Frame& F, const Args& a) {
    const bf16_t* MD = (const bf16_t*)(F.ws + WS_SLOT0 + 1 * SLOT_BYTES); const float* g4 = a.in[15];
    const int gw = F.vcu * NWAVE + F.wave, NGW = F.G * NWAVE;
    for (int m = gw; m < T; m += NGW) {
        const u32x2* mr = (const u32x2*)(MD + (size_t)m * DM) + F.lane; f32x4* orow = (f32x4*)(F.out + (size_t)m * DM) + F.lane;
        f32x4 v[4]; float s = 0.f;
#pragma unroll
        for (int j = 0; j < 4; ++j) { const u32x2 w = mr[64 * j]; v[j] = (f32x4){bflo(w.x), bfhi(w.x), bflo(w.y), bfhi(w.y)}; s += (v[j].x * v[j].x + v[j].y * v[j].y) + (v[j].z * v[j].z + v[j].w * v[j].w); }
        const float rs = 1.0f / sqrtf(wave_sum(s) * (1.0f / DM) + NORM_EPS);
#pragma unroll
        for (int j = 0; j < 4; ++j) { const f32x4 gv = ((const f32x4*)g4)[64 * j + F.lane]; orow[64 * j] = orow[64 * j] + v[j] * rs * gv; }
    }
}

#define XB_TMO      128
#define XB_XCNT(j)  (256  + 64 * (j))
#define XB_XSUB(j)  (1280 + 64 * (j))
#define XB_XGEN(j)  (2304 + 64 * (j))
#define XB_TOP      3328
#define XB_TOPGEN   3392
#define XCD_BAR_WORDS 3456
#define XB_SPIN_CAP (1u << 22)
__device__ __forceinline__ unsigned xb_ld(unsigned* p)              { return __hip_atomic_load(p, __ATOMIC_RELAXED, __HIP_MEMORY_SCOPE_AGENT); }
__device__ __forceinline__ unsigned xb_add(unsigned* p, unsigned v) { return __hip_atomic_fetch_add(p, v, __ATOMIC_RELAXED, __HIP_MEMORY_SCOPE_AGENT); }
__device__ __forceinline__ unsigned xb_xcc_id() { return (unsigned)__builtin_amdgcn_s_getreg((3 << 11) | 20) & 0xFu; }
#define XB_SPIN(cond, bar) do { unsigned _sp = 0; while (cond) { __builtin_amdgcn_s_sleep(1); \
    if ((++_sp & 255u) == 0u) { if (xb_ld(&(bar)[XB_TMO])) break; if (_sp > XB_SPIN_CAP) { atomicAdd(&(bar)[XB_TMO], 1u); break; } } } } while (0)
struct XcdBarrier { unsigned* bar; unsigned x; volatile unsigned* st; };
__device__ __forceinline__ XcdBarrier xcd_barrier_post(unsigned* bar, volatile unsigned* st) {
    XcdBarrier b; b.bar = bar; b.x = xb_xcc_id(); b.st = st;
    if (threadIdx.x == 0) (void)xb_add(&bar[XB_XCNT(b.x)], 1u);
    return b;
}
__device__ __forceinline__ void xcd_barrier_complete(unsigned* bar, unsigned x, unsigned& nloc, unsigned& nx) {
    const unsigned G = gridDim.x * gridDim.y * gridDim.z;
    unsigned sum, cnt, mine, sp = 0u;
    for (;;) {
        sum = 0u; cnt = 0u; mine = 0u;
#pragma unroll
        for (unsigned j = 0; j < 16; ++j) { const unsigned c = xb_ld(&bar[XB_XCNT(j)]); sum += c; cnt += (c > 0u) ? 1u : 0u; mine = (j == x) ? c : mine; }
        if (sum == G) break;
        __builtin_amdgcn_s_sleep(1);
        if ((++sp & 255u) == 0u) { if (xb_ld(&bar[XB_TMO])) break; if (sp > XB_SPIN_CAP) { atomicAdd(&bar[XB_TMO], 1u); break; } }
    }
    nloc = mine > 0u ? mine : 1u; nx = cnt > 0u ? cnt : 1u;
}
__device__ __forceinline__ void xcd_barrier(const XcdBarrier& b) {
    asm volatile("s_waitcnt vmcnt(0)" ::: "memory");
    __syncthreads();
    if (threadIdx.x == 0) {
        unsigned* bar = b.bar;
        __builtin_amdgcn_s_waitcnt(0);
        unsigned nloc = b.st[0], nx = b.st[1];
        if (nloc == 0u) { xcd_barrier_complete(bar, b.x, nloc, nx); b.st[0] = nloc; b.st[1] = nx; }
        const unsigned old = xb_add(&bar[XB_XSUB(b.x)], 1u);
        const unsigned gen = old / nloc;
        if (old + 1u == (gen + 1u) * nloc) {
            __builtin_amdgcn_fence(__ATOMIC_RELEASE, "agent");
            asm volatile("s_waitcnt vmcnt(0)" ::: "memory");
            const unsigned og = xb_add(&bar[XB_TOP], 1u);
            const unsigned tg = og / nx;
            if (og + 1u == (tg + 1u) * nx) xb_add(&bar[XB_TOPGEN], 1u);
            else XB_SPIN(xb_ld(&bar[XB_TOPGEN]) == tg, bar);
            __builtin_amdgcn_fence(__ATOMIC_ACQUIRE, "agent");
            xb_add(&bar[XB_XGEN(b.x)], 1u);
            asm volatile("s_waitcnt vmcnt(0)" ::: "memory");
        } else {
            XB_SPIN(xb_ld(&bar[XB_XGEN(b.x)]) == gen, bar);
            __builtin_amdgcn_fence(__ATOMIC_ACQUIRE, "agent");
            asm volatile("s_waitcnt vmcnt(0)" ::: "memory");
        }
    }
    __syncthreads();
}

#ifndef GEMM_BODY
#define GEMM_BODY gemm_fast
#endif

__global__ void __launch_bounds__(NTHR, 2) fwd_kernel(Args args) {
    extern __shared__ __attribute__((aligned(16))) unsigned char lds[];
    Frame F;
    F.lds = lds; F.tid = threadIdx.x; F.lane = F.tid & 63; F.wave = __builtin_amdgcn_readfirstlane(F.tid >> 6);
    F.G = gridDim.x; { const int bx = blockIdx.x; F.vcu = (F.G % 8 == 0) ? (bx % 8) * (F.G / 8) + bx / 8 : bx; }
    F.ws = args.ws; F.out = args.out;
    unsigned char* ws = args.ws;
    bf16_t* S0 = (bf16_t*)(ws + WS_SLOT0);
#define SL(i) ((bf16_t*)(ws + WS_SLOT0 + (size_t)(i) * SLOT_BYTES))
    const float* cosT = (const float*)(ws + WS_COS); const float* sinT = (const float*)(ws + WS_SIN);
    const int lo = args.ph_lo, hi = args.ph_hi;
    volatile unsigned* bst = (volatile unsigned*)(lds + LDS_BYTES - 64);
    if (F.tid < 16) ((volatile unsigned*)(lds + LDS_BYTES - 64))[F.tid] = 0u;
    __syncthreads();
    XcdBarrier bar; bar.bar = (unsigned*)(ws + WS_CTL) + 1024; bar.x = 0; bar.st = bst;
    if (hi - lo > 1) bar = xcd_barrier_post((unsigned*)(ws + WS_CTL) + 1024, bst);
#define IN(k) (lo <= (k) && (k) < hi && (refresh(F), true))
#define SEAM(k) do { if ((k) + 1 < hi) xcd_barrier(bar); } while (0)

    if (IN(0)) { p0_prologue(F, args); SEAM(0); }
    if (IN(1)) {
        { Gemm g{(const bf16_t*)args.out, nullptr, (const bf16_t*)(ws + WS_WIN), nullptr, DM, DM, DM, 0, 0};
          StaticOrder S; S.init(T, 6144, F.G, (int)blockIdx.x, 0);
          EpiStore<0, true, true> E{S0, DM, cosT, sinT};
          GEMM_BODY<DM, DM, DM, 0, 0, false>(F.lds, g, S, E); }
        { Gemm g{(const bf16_t*)(ws + WS_WIN) + (size_t)6144 * DM, nullptr, (const bf16_t*)args.out, nullptr, DM, DM, DM, 0, 0};
          StaticOrder S; S.init(DM, T, F.G, (int)blockIdx.x, 0);
          EpiStore<0, false, false> E{SL(2), T, nullptr, nullptr};
          GEMM_BODY<DM, DM, DM, 0, 0, false>(F.lds, g, S, E); }
        SEAM(1);
    }
    if (IN(2)) { p2_conv_kmean(F, args); SEAM(2); }
    if (IN(3)) {
        { Gemm g{(const bf16_t*)args.out, nullptr, (const bf16_t*)(ws + WS_WRG), nullptr, DM, 256, 256, 1, 256};
          StaticOrder S; S.init(T, 2048, F.G, (int)blockIdx.x, 0);
          EpiRG E{(const bf16_t*)args.out, (bf16_t*)((unsigned char*)args.out + SLOT_BYTES), SL(3), args.in[7], args.in[9], (const float*)(ws + WS_C8)};
          GEMM_BODY<DM, 256, 256, 1, 256, false>(F.lds, g, S, E); }
        p3_select(F);
        SEAM(3);
    }
    if (IN(4)) { p45_scan<1>(F); SEAM(4); }
    if (IN(5)) { p45_scan<2>(F); SEAM(5); }
    if (IN(6)) { p6_attn_sel(F); SEAM(6); }
    if (IN(7)) { p7_attn_own(F); SEAM(7); }
    if (IN(8)) {
        Gemm g{SL(0), SL(4), (const bf16_t*)(ws + WS_WBA), (const bf16_t*)(ws + WS_WBL), DM, DM, DM, 0, 0};
        StaticOrder S; S.init(T, DM, F.G, (int)blockIdx.x, 1);
        EpiBranch E{SL(5), SL(6), SL(1)};
        GEMM_BODY<DM, DM, DM, 0, 0, true>(F.lds, g, S, E);
        SEAM(8);
    }
    if (IN(9)) {
        Gemm g{SL(1), nullptr, (const bf16_t*)(ws + WS_WOUT), nullptr, DM, DM, DM, 0, 0};
        StaticOrder S; S.init(T, DM, F.G, (int)blockIdx.x, 0);
        EpiStore<0, false, false> E{SL(2), DM, nullptr, nullptr};
        GEMM_BODY<DM, DM, DM, 0, 0, false>(F.lds, g, S, E);
        SEAM(9);
    }
    if (IN(10)) { p10_norm_mid(F, args); SEAM(10); }
    if (IN(11)) {
        Gemm g{SL(0), nullptr, (const bf16_t*)(ws + WS_WUP), nullptr, DM, DM, DM, 0, 0};
        StaticOrder S; S.init(T, FF, F.G, (int)blockIdx.x, 0);
        EpiStore<1, false, false> E{SL(3), FF, nullptr, nullptr};
        GEMM_BODY<DM, DM, DM, 0, 0, false>(F.lds, g, S, E);
        SEAM(11);
    }
    if (IN(12)) {
        Gemm g{SL(3), nullptr, (const bf16_t*)(ws + WS_WDN), nullptr, FF, FF, FF, 0, 0};
        StaticOrder S; S.init(T, DM, F.G, (int)blockIdx.x, 0);
        EpiStore<0, false, false> E{SL(1), DM, nullptr, nullptr};
        GEMM_BODY<FF, FF, FF, 0, 0, false>(F.lds, g, S, E);
        SEAM(12);
    }
    if (IN(13)) { p13_norm_final(F, args); }
}

extern "C" void kernel_launch(void* const* d_in, const int* in_sizes, int n_in, void* d_out, int out_size, void* d_ws, size_t ws_size, hipStream_t stream) {
    static int grid = 0;
    if (grid == 0) {
        if (n_in != 18 || out_size != T * DM || ws_size < WS_END) { fprintf(stderr, "kernel_launch: unexpected shapes (n_in %d out %d ws %zu)\n", n_in, out_size, ws_size); grid = -1; return; }
        int dev = 0, cus = 0;
        if (hipGetDevice(&dev) != hipSuccess || hipDeviceGetAttribute(&cus, hipDeviceAttributeMultiprocessorCount, dev) != hipSuccess) { grid = -1; return; }
        if (hipFuncSetAttribute((const void*)fwd_kernel, hipFuncAttributeMaxDynamicSharedMemorySize, LDS_BYTES) != hipSuccess) { fprintf(stderr, "kernel_launch: hipFuncSetAttribute failed\n"); grid = -1; return; }
        grid = cus;
    }
    if (grid < 0) return;
    Args a{};
    for (int i = 0; i < 18; ++i) a.in[i] = (const float*)d_in[i];
    a.out = (float*)d_out; a.ws = (unsigned char*)d_ws;
#if N_LAUNCH_MODE == 0
    for (int ph = 0; ph < NPHASE; ++ph) {
        a.ph_lo = ph; a.ph_hi = ph + 1;
        hipLaunchKernelGGL(fwd_kernel, dim3(grid), dim3(NTHR), LDS_BYTES, stream, a);
    }
#else
    (void)hipMemsetAsync((char*)d_ws + WS_CTL, 0, 65536, stream);
    a.ph_lo = 0; a.ph_hi = NPHASE;
    hipLaunchKernelGGL(fwd_kernel, dim3(grid), dim3(NTHR), LDS_BYTES, stream, a);
#endif
}
```

```cpp
#include <hip/hip_runtime.h>
#include <cstdio>
#include <cstdint>

#ifndef PROBE_PH
#define PROBE_PH -1
#endif
#ifndef PROBE_T
#define PROBE_T -1
#endif
#ifndef N_LAUNCH_MODE
#define N_LAUNCH_MODE 1
#endif

typedef unsigned short bf16_t;
typedef short bf16x8 __attribute__((ext_vector_type(8)));
typedef short bf16x4 __attribute__((ext_vector_type(4)));
typedef float f32x4 __attribute__((ext_vector_type(4)));
typedef float f32x16 __attribute__((ext_vector_type(16)));
typedef unsigned u32x4 __attribute__((ext_vector_type(4)));
typedef unsigned u32x2 __attribute__((ext_vector_type(2)));
#define LAS __attribute__((address_space(3)))

constexpr int BATCH = 4, SEQ = 8192, DM = 1024, NH = 8, HD = 128, FF = 4096;
constexpr int T = BATCH * SEQ;
constexpr int NBLK = SEQ / 256;
constexpr int NBH = BATCH * NH;
constexpr int NTHR = 512, NWAVE = 8;
constexpr int LDS_BYTES = 147456;
constexpr float NORM_EPS = 1e-6f;
constexpr int NPHASE = 14;

constexpr size_t MiB = 1u << 20;
constexpr size_t WS_CTL = 0;
constexpr size_t WS_WIN = 1 * MiB;
constexpr size_t WS_WRG = 15 * MiB;
constexpr size_t WS_WBA = 16 * MiB, WS_WBL = 18 * MiB, WS_WOUT = 20 * MiB;
constexpr size_t WS_WUP = 22 * MiB;
constexpr size_t WS_WDN = 30 * MiB;
constexpr size_t WS_SLOT0 = 40 * MiB, SLOT_BYTES = 64 * MiB;
constexpr size_t SLOT_ELEMS = SLOT_BYTES / 2;
constexpr size_t WS_TAIL = 488 * MiB;
constexpr size_t WS_COS = WS_TAIL, WS_SIN = WS_TAIL + 512 * 1024;
constexpr size_t WS_KM = WS_TAIL + 1 * MiB;
constexpr size_t WS_CNT = WS_TAIL + 1 * MiB + 512 * 1024;
constexpr size_t WS_SUMLA = WS_TAIL + 2 * MiB, WS_SUMH = WS_TAIL + 3 * MiB;
constexpr size_t WS_LSE = WS_TAIL + 4 * MiB;
constexpr size_t WS_LIST = WS_TAIL + 7 * MiB;
constexpr size_t WS_C8 = WS_TAIL + 23 * MiB;
constexpr size_t WS_KMH = WS_TAIL + 23 * MiB + 64 * 1024, WS_KML = WS_KMH + 256 * 1024;
constexpr size_t WS_RS2 = WS_TAIL + 23 * MiB + 640 * 1024;
constexpr size_t WS_END = 512 * MiB;


struct Args { const float* in[18]; float* out; unsigned char* ws; int ph_lo, ph_hi; };

__device__ __forceinline__ unsigned cvt_pk_bf16(float lo, float hi) { unsigned r; asm volatile("v_cvt_pk_bf16_f32 %0, %1, %2" : "=v"(r) : "v"(lo), "v"(hi)); return r; }
__device__ __forceinline__ unsigned f2bf(float f) { unsigned u = __float_as_uint(f); return (u + 0x7fffu + ((u >> 16) & 1u)) >> 16; }
__device__ __forceinline__ unsigned pk2(float lo, float hi) { return f2bf(lo) | (f2bf(hi) << 16); }
__device__ __forceinline__ float bflo(unsigned w) { return __uint_as_float(w << 16); }
__device__ __forceinline__ float bfhi(unsigned w) { return __uint_as_float(w & 0xffff0000u); }
__device__ __forceinline__ float bf1(bf16_t u) { return __uint_as_float((unsigned)u << 16); }
__device__ __forceinline__ float sigmoidf_(float x) { return __builtin_amdgcn_rcpf(1.0f + __expf(-x)); }
__device__ __forceinline__ float gelu_tanh(float x) {
    const float z = 0.7978845608028654f * (x + 0.044715f * x * x * x);
    return x * sigmoidf_(2.0f * z);
}
__device__ __forceinline__ float wave_sum(float v) {
#pragma unroll
    for (int o = 1; o < 64; o <<= 1) v += __shfl_xor(v, o);
    return v;
}
__device__ __forceinline__ int crow(int r, int hi) { return (r & 3) + 8 * (r >> 2) + 4 * hi; }

struct Frame {
    unsigned char* lds; int tid, lane, wave, vcu, G, dummy;
    unsigned char* ws; float* out;
};
__device__ __forceinline__ void refresh(Frame& F) { int t = threadIdx.x; asm volatile("" : "+v"(t)); F.tid = t; F.lane = t & 63; F.wave = __builtin_amdgcn_readfirstlane(t >> 6); }

__host__ __device__ __forceinline__ int perm32(int rho) { const int n = rho >> 4, i = rho & 15; return 8 * (i >> 2) + 4 * n + (i & 3); }
struct Unit { int pm, pn, seg; };
struct Gemm { const bf16_t* A0; const bf16_t* A1; const bf16_t* B0; const bf16_t* B1; int lda, ldb, K, a_grp_shift, a_grp_stride; };

constexpr int NXCD = 8, WGM = 8;
struct StaticOrder {
    int nM, nN, nwg, G, c, dual;
    __device__ void init(int M, int N, int G_, int c_, int dual_) { nM = M / 256; nN = N / 256; nwg = nM * nN; G = G_; c = c_; dual = dual_; }
    __device__ bool next(int i, Unit& u) const {
        const int ip = dual ? (i >> 1) : i; u.seg = dual ? (i & 1) : 0;
        const long L = (long)ip * G + c; if (L >= nwg) return false;
        int wgid = (int)L; { const int q = nwg / NXCD, r = nwg % NXCD, xcd = wgid % NXCD, off = wgid / NXCD; wgid = (xcd < r ? xcd * (q + 1) : r * (q + 1) + (xcd - r) * q) + off; }
        const int nig = WGM * nN, gid = wgid / nig, fm = gid * WGM, gsz = (nM - fm) < WGM ? (nM - fm) : WGM;
        u.pm = fm + ((wgid % nig) % gsz); u.pn = (wgid % nig) / gsz; return true;
    }
};

template <int LDA_, int LDB_, int KK_, int GSH_, int GST_, bool DUAL_, class Epi, class Sched>
__device__ __forceinline__ void gemm_simple(unsigned char* lds, const Gemm g, const Sched& S, const Epi& E) {
    const int tid = threadIdx.x, wid = __builtin_amdgcn_readfirstlane(tid >> 6), lane = tid & 63, wr = wid >> 2, wc = wid & 3, fr = lane & 15, fq = lane >> 4;
    constexpr int RS = 80;
    unsigned char* As = lds; unsigned char* Bs = lds + 256 * RS;
    const int row = tid >> 2, c4 = tid & 3;
    const int brow = Epi::PERM ? ((row & ~31) + perm32(row & 31)) : row;
    Unit u;
    for (int ui = 0; S.next(ui, u); ++ui) {
        f32x4 acc[2][2][4][2];
#pragma unroll
        for (int a = 0; a < 2; ++a)
#pragma unroll
            for (int b = 0; b < 2; ++b)
#pragma unroll
                for (int m = 0; m < 4; ++m)
#pragma unroll
                    for (int n = 0; n < 2; ++n) acc[a][b][m][n] = (f32x4){0.f, 0.f, 0.f, 0.f};
        const bf16_t* A = (u.seg ? g.A1 : g.A0) + (size_t)u.pm * 256 * g.lda + (size_t)(u.pn >> g.a_grp_shift) * g.a_grp_stride + (size_t)row * g.lda + c4 * 8;
        const bf16_t* Bt = (u.seg ? g.B1 : g.B0) + (size_t)u.pn * 256 * g.ldb + (size_t)brow * g.ldb + c4 * 8;
        const size_t a128 = (size_t)128 * g.lda, b128 = (size_t)128 * g.ldb;
        for (int k0 = 0; k0 < g.K; k0 += 32) {
            const u32x4 va0 = *(const u32x4*)(A + k0), va1 = *(const u32x4*)(A + a128 + k0);
            const u32x4 vb0 = *(const u32x4*)(Bt + k0), vb1 = *(const u32x4*)(Bt + b128 + k0);
            __syncthreads();
            *(u32x4*)(As + row * RS + c4 * 16) = va0; *(u32x4*)(As + (row + 128) * RS + c4 * 16) = va1;
            *(u32x4*)(Bs + row * RS + c4 * 16) = vb0; *(u32x4*)(Bs + (row + 128) * RS + c4 * 16) = vb1;
            __syncthreads();
            bf16x8 Bf[2][2];
#pragma unroll
            for (int bj = 0; bj < 2; ++bj)
#pragma unroll
                for (int n = 0; n < 2; ++n) Bf[bj][n] = *(const bf16x8*)(Bs + (128 * bj + 32 * wc + 16 * n + fr) * RS + fq * 16);
#pragma unroll
            for (int ai = 0; ai < 2; ++ai) {
                bf16x8 Af[4];
#pragma unroll
                for (int m = 0; m < 4; ++m) Af[m] = *(const bf16x8*)(As + (128 * ai + 64 * wr + 16 * m + fr) * RS + fq * 16);
#pragma unroll
                for (int bj = 0; bj < 2; ++bj)
#pragma unroll
                    for (int m = 0; m < 4; ++m)
#pragma unroll
                        for (int n = 0; n < 2; ++n) acc[ai][bj][m][n] = __builtin_amdgcn_mfma_f32_16x16x32_bf16(Bf[bj][n], Af[m], acc[ai][bj][m][n], 0, 0, 0);
            }
        }
        asm volatile("" ::: "memory");
        E(acc, u, wr, wc, fr, fq);
    }
    __syncthreads();
}


namespace pg8 {
constexpr int BM = 256, BK = 64, HALF = 128, HTB = HALF * BK * 2, STAGE_BYTES = 8 * HTB;
__host__ __device__ __forceinline__ int lds_byte(int r, int c) { const int st = (r >> 4) * 2 + (c >> 5), rr = r & 15, cc = c & 31, ob = rr * 64 + cc * 2; return st * 1024 + (ob ^ (((ob >> 9) & 1) << 5)); }
__host__ __device__ __forceinline__ void stage_rc(int b, int& R, int& C) { const int st = b / 1024, sb = b % 1024, swz = sb ^ (((sb >> 9) & 1) << 5); R = (st >> 1) * 16 + swz / 64; C = (st & 1) * 32 + (swz % 64) / 2; }

template <class Epi, class Sched, int LDA, int LDB, int KK, int GSH, int GST, bool DUAL>
__device__ __forceinline__ void gemm_phase(LAS unsigned char* lds, const Gemm g, const Sched& S, const Epi& E) {
    int tid = threadIdx.x; asm volatile("" : "+v"(tid));
    const int wid = __builtin_amdgcn_readfirstlane(tid >> 6), lane = tid & 63, wr = wid >> 2, wc = wid & 3, fr = lane & 15, fq = lane >> 4;
    constexpr int K = KK, nt = K / BK;
    const __amdgpu_buffer_rsrc_t rA0 = __builtin_amdgcn_make_buffer_rsrc((void*)g.A0, 0, 0x7ffffffe, 0x00020000);
    const __amdgpu_buffer_rsrc_t rB0 = __builtin_amdgcn_make_buffer_rsrc((void*)g.B0, 0, 0x7ffffffe, 0x00020000);
    const __amdgpu_buffer_rsrc_t rA1 = __builtin_amdgcn_make_buffer_rsrc((void*)(DUAL ? g.A1 : g.A0), 0, 0x7ffffffe, 0x00020000);
    const __amdgpu_buffer_rsrc_t rB1 = __builtin_amdgcn_make_buffer_rsrc((void*)(DUAL ? g.B1 : g.B0), 0, 0x7ffffffe, 0x00020000);
    int voffA[2], voffB[2];
#pragma unroll
    for (int i = 0; i < 2; ++i) { int R, C; stage_rc(tid * 16 + i * 8192, R, C); const int Rb = Epi::PERM ? ((R & ~31) + perm32(R & 31)) : R;
        voffA[i] = (R * LDA + C) * 2; voffB[i] = (Rb * LDB + C) * 2; }
    constexpr int kstep = BK * 2;
    constexpr int hstepA = HALF * LDA * 2, hstepB = HALF * LDB * 2;
    const unsigned ldsw = (unsigned)wid * 1024u;
    const int aoff = lds_byte(wr * 64 + fr, fq * 8), boff = lds_byte(wc * 32 + fr, fq * 8);
#define PG8_UA(u) (((u).pm * 256 * LDA + ((u).pn >> GSH) * GST) * 2)
#define PG8_UB(u) ((u).pn * 256 * LDB * 2)
#define PG8_SA(b, h) (((b) * 2 + (h)) * HTB)
#define PG8_SB(b, h) ((4 + (b) * 2 + (h)) * HTB)
#define PG8_STAGE_A(bufoff, sg, soff) do { _Pragma("unroll") for (int _i = 0; _i < 2; ++_i) \
        __builtin_amdgcn_raw_ptr_buffer_load_lds((DUAL && (sg)) ? rA1 : rA0, (LAS unsigned*)(lds + (bufoff) + ldsw + _i * 8192), 16, voffA[_i], (soff), 0, 0); } while (0)
#define PG8_STAGE_B(bufoff, sg, soff) do { _Pragma("unroll") for (int _i = 0; _i < 2; ++_i) \
        __builtin_amdgcn_raw_ptr_buffer_load_lds((DUAL && (sg)) ? rB1 : rB0, (LAS unsigned*)(lds + (bufoff) + ldsw + _i * 8192), 16, voffB[_i], (soff), 0, 0); } while (0)
#define PG8_LDA(dst, b, h) do { _Pragma("unroll") for (int m = 0; m < 4; ++m) _Pragma("unroll") for (int k = 0; k < 2; ++k) dst[m][k] = *(const LAS bf16x8*)(lds + PG8_SA(b, h) + aoff + m * 2048 + k * 1024); } while (0)
#define PG8_LDB(dst, b, h) do { _Pragma("unroll") for (int n = 0; n < 2; ++n) _Pragma("unroll") for (int k = 0; k < 2; ++k) dst[n][k] = *(const LAS bf16x8*)(lds + PG8_SB(b, h) + boff + n * 2048 + k * 1024); } while (0)
#define PG8_MMA(ai, bj, At, Bt) do { __builtin_amdgcn_s_setprio(1); _Pragma("unroll") for (int m = 0; m < 4; ++m) _Pragma("unroll") for (int n = 0; n < 2; ++n) _Pragma("unroll") for (int k = 0; k < 2; ++k) \
        acc[ai][bj][m][n] = __builtin_amdgcn_mfma_f32_16x16x32_bf16(Bt[n][k], At[m][k], acc[ai][bj][m][n], 0, 0, 0); __builtin_amdgcn_s_setprio(0); } while (0)
#define PG8_WAIT_V(n) asm volatile("s_waitcnt vmcnt(" #n ")" ::: "memory")
#define PG8_WAIT_L(n) asm volatile("s_waitcnt lgkmcnt(" #n ")" ::: "memory")
#define PG8_BAR __builtin_amdgcn_s_barrier()
#define PG8_SCHED __builtin_amdgcn_sched_barrier(0)
    Unit cur, nxt; int ui = 0;
    if (!S.next(0, cur)) return;
    f32x4 acc[2][2][4][2];
#pragma unroll
    for (int a = 0; a < 2; ++a)
#pragma unroll
        for (int b = 0; b < 2; ++b)
#pragma unroll
            for (int m = 0; m < 4; ++m)
#pragma unroll
                for (int n = 0; n < 2; ++n) acc[a][b][m][n] = (f32x4){0.f, 0.f, 0.f, 0.f};
    bf16x8 At[4][2], B0[2][2], B1[2][2];
    int cA = PG8_UA(cur), cB = PG8_UB(cur), cs = cur.seg;
    PG8_STAGE_B(PG8_SB(0, 0), cs, cB); PG8_STAGE_B(PG8_SB(0, 1), cs, cB + hstepB); PG8_STAGE_A(PG8_SA(0, 0), cs, cA); PG8_STAGE_A(PG8_SA(0, 1), cs, cA + hstepA);
    if (wr == 1) PG8_BAR;
    PG8_WAIT_V(2); PG8_BAR;
    PG8_STAGE_B(PG8_SB(1, 0), cs, cB + kstep); PG8_STAGE_A(PG8_SA(1, 0), cs, cA + kstep); PG8_STAGE_B(PG8_SB(1, 1), cs, cB + hstepB + kstep);
    PG8_WAIT_V(6); PG8_BAR;
    for (;;) {
        const bool has_next = S.next(ui + 1, nxt);
        const int nA = has_next ? PG8_UA(nxt) : cA, nB = has_next ? PG8_UB(nxt) : cB, ns = has_next ? nxt.seg : cs;
        for (int t = 0; t < nt; t += 2) {
            const bool last = (t == nt - 2);
            const int a1 = cA + (t + 1) * kstep;
            const int a2 = last ? nA : cA + (t + 2) * kstep, b2 = last ? nB : cB + (t + 2) * kstep, s2 = last ? ns : cs;
            const int a3 = a2 + kstep, b3 = b2 + kstep;
            PG8_LDB(B0, 0, 0); PG8_LDB(B1, 0, 1); PG8_SCHED; PG8_LDA(At, 0, 0); PG8_STAGE_A(PG8_SA(1, 1), cs, a1 + hstepA);
            PG8_WAIT_V(8); PG8_WAIT_L(0); PG8_BAR; PG8_MMA(0, 0, At, B0); PG8_MMA(0, 1, At, B1); PG8_BAR; PG8_SCHED;
            PG8_LDA(At, 0, 1); PG8_STAGE_B(PG8_SB(0, 0), s2, b2); PG8_STAGE_B(PG8_SB(0, 1), s2, b2 + hstepB); PG8_STAGE_A(PG8_SA(0, 0), s2, a2);
            PG8_WAIT_V(8); PG8_WAIT_L(0); PG8_BAR; PG8_MMA(1, 0, At, B0); PG8_MMA(1, 1, At, B1); PG8_BAR; PG8_SCHED;
            PG8_LDB(B0, 1, 0); PG8_LDB(B1, 1, 1); PG8_SCHED; PG8_LDA(At, 1, 0); PG8_STAGE_A(PG8_SA(0, 1), s2, a2 + hstepA);
            PG8_WAIT_V(8); PG8_WAIT_L(0); PG8_BAR; PG8_MMA(0, 0, At, B0); PG8_MMA(0, 1, At, B1); PG8_BAR; PG8_SCHED;
            PG8_LDA(At, 1, 1); PG8_STAGE_B(PG8_SB(1, 0), s2, b3); PG8_STAGE_B(PG8_SB(1, 1), s2, b3 + hstepB); PG8_STAGE_A(PG8_SA(1, 0), s2, a3);
            PG8_WAIT_V(8); PG8_WAIT_L(0); PG8_BAR; PG8_MMA(1, 0, At, B0); PG8_MMA(1, 1, At, B1); PG8_BAR; PG8_SCHED;
        }
        if (wr == 0) PG8_BAR;
        asm volatile("" ::: "memory");
        E(acc, cur, wr, wc, fr, fq);
        if (!has_next) break;
#pragma unroll
        for (int a = 0; a < 2; ++a)
#pragma unroll
            for (int b = 0; b < 2; ++b)
#pragma unroll
                for (int m = 0; m < 4; ++m)
#pragma unroll
                    for (int n = 0; n < 2; ++n) acc[a][b][m][n] = (f32x4){0.f, 0.f, 0.f, 0.f};
        cur = nxt; cA = nA; cB = nB; cs = ns; ++ui;
        if (wr == 1) PG8_BAR;
    }
    PG8_WAIT_V(0);
    PG8_BAR;
#undef PG8_UA
#undef PG8_UB
#undef PG8_SA
#undef PG8_SB
#undef PG8_STAGE_A
#undef PG8_STAGE_B
#undef PG8_LDA
#undef PG8_LDB
#undef PG8_MMA
#undef PG8_WAIT_V
#undef PG8_WAIT_L
#undef PG8_BAR
#undef PG8_SCHED
}
}
template <int LDA, int LDB, int KK, int GSH, int GST, bool DUAL, class Epi, class Sched>
__device__ __forceinline__ void gemm_fast(unsigned char* lds, const Gemm g, const Sched& S, const Epi& E) { pg8::gemm_phase<Epi, Sched, LDA, LDB, KK, GSH, GST, DUAL>((LAS unsigned char*)lds, g, S, E); }

template <int ACT, bool SPLIT, bool ROPE> struct EpiStore {
    static constexpr bool PERM = true;
    bf16_t* O; int ldc; const float* cosT; const float* sinT; const float* rowscale; float* kmean;
    __device__ __forceinline__ void operator()(const f32x4 (&acc)[2][2][4][2], const Unit& u, int wr, int wc, int fr, int fq) const {
        const int row0 = u.pm * 256 + wr * 64 + fr; int colt = u.pn * 256; bf16_t* base = O;
        if (SPLIT) { const int sidx = u.pn >> 2; const int slot = sidx + (sidx >= 2 ? 1 : 0); base = O + (size_t)slot * SLOT_ELEMS; colt = (u.pn & 3) * 256; }
        const int col0 = colt + wc * 32 + 8 * fq;
        const bool rope = ROPE && (u.pn < 8) && (wc == 0);
        const bool ktile = SPLIT && (u.pn >= 4) && (u.pn < 8);
        float cs[2][8];
#pragma unroll
        for (int bj = 0; bj < 2; ++bj)
#pragma unroll
            for (int e = 0; e < 8; ++e) cs[bj][e] = 0.f;
#pragma unroll
        for (int ai = 0; ai < 2; ++ai)
#pragma unroll
            for (int m = 0; m < 4; ++m) {
                const int row = row0 + ai * 128 + m * 16; bf16_t* rowp = base + (size_t)row * ldc + col0;
                float rs2 = 1.f; if (ACT == 1 && rowscale) { const float r = rowscale[row]; rs2 = r * r; }
                f32x4 c0, c1, s0, s1;
                if (rope) { const int pos = row & (SEQ - 1); const float* cp = cosT + pos * 16 + 8 * (fq & 1); const float* sp = sinT + pos * 16 + 8 * (fq & 1);
                    c0 = *(const f32x4*)cp; c1 = *(const f32x4*)(cp + 4); s0 = *(const f32x4*)sp; s1 = *(const f32x4*)(sp + 4); }
#pragma unroll
                for (int bj = 0; bj < 2; ++bj) {
                    f32x4 v0 = acc[ai][bj][m][0], v1 = acc[ai][bj][m][1];
                    if (rope) {
                        f32x4 p0, p1;
#pragma unroll
                        for (int j = 0; j < 4; ++j) { p0[j] = __shfl_xor(v0[j], 32); p1[j] = __shfl_xor(v1[j], 32); }
                        if (fq < 2) { v0 = v0 * c0 - p0 * s0; v1 = v1 * c1 - p1 * s1; }
                        else        { v0 = v0 * c0 + p0 * s0; v1 = v1 * c1 + p1 * s1; }
                    }
                    if (ACT == 1) {
#pragma unroll
                        for (int j = 0; j < 4; ++j) { const float a = fmaxf(v0[j], 0.f), b = fmaxf(v1[j], 0.f); v0[j] = a * a * rs2; v1[j] = b * b * rs2; }
                    }
                    if (SPLIT) {
#pragma unroll
                        for (int j = 0; j < 4; ++j) { cs[bj][j] += v0[j]; cs[bj][4 + j] += v1[j]; } }
                    u32x4 w; w.x = cvt_pk_bf16(v0[0], v0[1]); w.y = cvt_pk_bf16(v0[2], v0[3]); w.z = cvt_pk_bf16(v1[0], v1[1]); w.w = cvt_pk_bf16(v1[2], v1[3]);
                    *(u32x4*)(rowp + bj * 128) = w;
                }
            }
        if (SPLIT && ktile) {
            const int b = u.pm >> 5, blk = u.pm & 31;
#pragma unroll
            for (int bj = 0; bj < 2; ++bj)
#pragma unroll
                for (int e = 0; e < 8; ++e) { float v = cs[bj][e]; v += __shfl_xor(v, 1); v += __shfl_xor(v, 2); v += __shfl_xor(v, 4); v += __shfl_xor(v, 8); cs[bj][e] = v; }
            if (fr == 0) {
#pragma unroll
                for (int bj = 0; bj < 2; ++bj) { float* kp = kmean + ((size_t)((b * NH + (u.pn & 3) * 2 + bj) * NBLK + blk)) * HD + wc * 32 + 8 * fq;
#pragma unroll
                    for (int e = 0; e < 8; ++e) atomicAdd(kp + e, cs[bj][e] * (1.0f / 256.0f)); }
            }
        }
    }
};

struct EpiRG {
    static constexpr bool PERM = true;
    const bf16_t* XC; bf16_t* LA; bf16_t* BX; const float* ba; const float* bi; const float* c8;
    __device__ __forceinline__ void operator()(const f32x4 (&acc)[2][2][4][2], const Unit& u, int wr, int wc, int fr, int fq) const {
        const int row0 = u.pm * 256 + wr * 64 + fr;
        const int ch0 = (u.pn >> 1) * 256 + (u.pn & 1) * 128 + wc * 32 + 8 * fq;
        u32x4 xw[8];
#pragma unroll
        for (int t = 0; t < 8; ++t) xw[t] = *(const u32x4*)(XC + (size_t)(row0 + (t >> 2) * 128 + (t & 3) * 16) * DM + ch0);
        constexpr float NL2E = -1.4426950408889634f;
        float vba[8], vbi[8], vc8[8];
#pragma unroll
        for (int e = 0; e < 8; ++e) { vba[e] = ba[ch0 + e] * NL2E; vbi[e] = bi[ch0 + e] * NL2E; vc8[e] = c8[ch0 + e]; }
#pragma unroll
        for (int t = 0; t < 8; ++t) {
            const int ai = t >> 2, m = t & 3;
            const size_t off = (size_t)(row0 + ai * 128 + m * 16) * DM + ch0;
            const float xc[8] = {bflo(xw[t].x), bfhi(xw[t].x), bflo(xw[t].y), bfhi(xw[t].y), bflo(xw[t].z), bfhi(xw[t].z), bflo(xw[t].w), bfhi(xw[t].w)};
            float la[8], ix[8];
#pragma unroll
            for (int e = 0; e < 8; ++e) {
                const float r = __builtin_amdgcn_rcpf(1.0f + __builtin_amdgcn_exp2f(fmaf(acc[ai][0][m][e >> 2][e & 3], NL2E, vba[e])));
                const float ig = __builtin_amdgcn_rcpf(1.0f + __builtin_amdgcn_exp2f(fmaf(acc[ai][1][m][e >> 2][e & 3], NL2E, vbi[e])));
                la[e] = vc8[e] * r;
                ix[e] = ig * xc[e];
            }
            u32x4 w; w.x = cvt_pk_bf16(la[0], la[1]); w.y = cvt_pk_bf16(la[2], la[3]); w.z = cvt_pk_bf16(la[4], la[5]); w.w = cvt_pk_bf16(la[6], la[7]);
            *(u32x4*)(LA + off) = w;
            w.x = cvt_pk_bf16(ix[0], ix[1]); w.y = cvt_pk_bf16(ix[2], ix[3]); w.z = cvt_pk_bf16(ix[4], ix[5]); w.w = cvt_pk_bf16(ix[6], ix[7]);
            *(u32x4*)(BX + off) = w;
        }
    }
};

struct EpiBranch {
    static constexpr bool PERM = true;
    const bf16_t* GA; const bf16_t* GL; bf16_t* MG;
    __device__ __forceinline__ void operator()(const f32x4 (&acc)[2][2][4][2], const Unit& u, int wr, int wc, int fr, int fq) const {
        const int row0 = u.pm * 256 + wr * 64 + fr, col0 = u.pn * 256 + wc * 32 + 8 * fq;
        const bf16_t* gate = u.seg ? GL : GA;
#pragma unroll
        for (int ai = 0; ai < 2; ++ai) {
            u32x4 gw[8], pw[8];
#pragma unroll
            for (int t = 0; t < 8; ++t) { const size_t off = (size_t)(row0 + ai * 128 + (t >> 1) * 16) * DM + col0 + (t & 1) * 128;
                gw[t] = *(const u32x4*)(gate + off); pw[t] = u.seg ? *(const u32x4*)(MG + off) : (u32x4){0u, 0u, 0u, 0u}; }
#pragma unroll
            for (int t = 0; t < 8; ++t) { const int m = t >> 1, bj = t & 1;
                const size_t off = (size_t)(row0 + ai * 128 + m * 16) * DM + col0 + bj * 128;
                const float gv[8] = {bflo(gw[t].x), bfhi(gw[t].x), bflo(gw[t].y), bfhi(gw[t].y), bflo(gw[t].z), bfhi(gw[t].z), bflo(gw[t].w), bfhi(gw[t].w)};
                const float pv[8] = {bflo(pw[t].x), bfhi(pw[t].x), bflo(pw[t].y), bfhi(pw[t].y), bflo(pw[t].z), bfhi(pw[t].z), bflo(pw[t].w), bfhi(pw[t].w)};
                float o[8];
#pragma unroll
                for (int e = 0; e < 8; ++e) o[e] = pv[e] + sigmoidf_(gv[e]) * acc[ai][bj][m][e >> 2][e & 3];
                u32x4 w; w.x = cvt_pk_bf16(o[0], o[1]); w.y = cvt_pk_bf16(o[2], o[3]); w.z = cvt_pk_bf16(o[4], o[5]); w.w = cvt_pk_bf16(o[6], o[7]);
                *(u32x4*)(MG + off) = w; }
        }
    }
};

__device__ __forceinline__ void transpose_item(const float* W, int ldw, int k0, int n0, bf16_t* dst, int Kd, float* scr, int lane, const float* kscale = nullptr) {
    float wv[32];
#pragma unroll
    for (int i = 0; i < 32; ++i) { const int kk = 2 * i + (lane >> 5); wv[i] = W[(size_t)(k0 + kk) * ldw + n0 + (lane & 31)]; }
    if (kscale) {
#pragma unroll
        for (int i = 0; i < 32; ++i) wv[i] *= kscale[k0 + 2 * i + (lane >> 5)]; }
#pragma unroll
    for (int i = 0; i < 32; ++i) { const int kk = 2 * i + (lane >> 5); scr[kk * 33 + (lane & 31)] = wv[i]; }
    asm volatile("s_waitcnt lgkmcnt(0)" ::: "memory");
    const int c = lane & 7;
#pragma unroll
    for (int j = 0; j < 4; ++j) { const int n = (lane >> 3) + 8 * j; const float* s = scr + (8 * c) * 33 + n;
        u32x4 o; o.x = pk2(s[0 * 33], s[1 * 33]); o.y = pk2(s[2 * 33], s[3 * 33]); o.z = pk2(s[4 * 33], s[5 * 33]); o.w = pk2(s[6 * 33], s[7 * 33]);
        *(u32x4*)(dst + (size_t)n * Kd + k0 + 8 * c) = o; }
    asm volatile("s_waitcnt lgkmcnt(0)" ::: "memory");
}
__device__ __forceinline__ void rms_row_to_bf16(const float* xrow, const float* gain, bf16_t* orow, int lane) {
    const f32x4* xr = (const f32x4*)xrow + lane; const f32x4* gr = (const f32x4*)gain + lane;
    f32x4 v[4]; float s = 0.f;
#pragma unroll
    for (int j = 0; j < 4; ++j) { v[j] = xr[64 * j]; s += (v[j].x * v[j].x + v[j].y * v[j].y) + (v[j].z * v[j].z + v[j].w * v[j].w); }
    const float rs = 1.0f / sqrtf(wave_sum(s) * (1.0f / DM) + NORM_EPS);
    u32x2* o8 = (u32x2*)orow + lane;
#pragma unroll
    for (int j = 0; j < 4; ++j) { const f32x4 gv = gr[64 * j]; u32x2 w; w.x = cvt_pk_bf16(v[j].x * rs * gv.x, v[j].y * rs * gv.y); w.y = cvt_pk_bf16(v[j].z * rs * gv.z, v[j].w * rs * gv.w); o8[64 * j] = w; }
}

__device__ __forceinline__ void p0_prologue(const Frame& F, const Args& a) {
    float* scr = (float*)(F.lds + F.wave * 16384);
    const int gw = F.vcu * NWAVE + F.wave, NGW = F.G * NWAVE;
    bf16_t* WinT = (bf16_t*)(F.ws + WS_WIN); bf16_t* WrgT = (bf16_t*)(F.ws + WS_WRG);
    constexpr int I_IN = 16 * 224, I_RG = 256, I_SQ = 16 * 32, I_UP = 16 * 128, I_DN = 64 * 32;
    constexpr int NITEMS = I_IN + I_RG + 3 * I_SQ + I_UP + I_DN;
    for (int it = gw; it < NITEMS; it += NGW) {
        int r = it;
        if (r < I_IN) { const int kb = r / 224, nb = r % 224, n0 = nb * 32;
            const int drow = (n0 < 2048) ? n0 : (n0 < 3072 ? 6144 + (n0 - 2048) : n0 - 1024);
            transpose_item(a.in[3], 7168, kb * 64, n0, WinT + (size_t)drow * 1024, 1024, scr, F.lane); continue; }
        r -= I_IN;
        if (r < I_RG) { const int which = r >> 7, g = (r >> 5) & 3, q = r & 31, kb = q >> 3, nb = q & 7, n0 = nb * 32;
            const float* W = a.in[which ? 8 : 6] + (size_t)g * 65536;
            const int tile = 2 * g + (n0 >> 7), drow = tile * 256 + which * 128 + (n0 & 127);
            transpose_item(W, 256, kb * 64, n0, WrgT + (size_t)drow * 256, 256, scr, F.lane); continue; }
        r -= I_RG;
        if (r < 3 * I_SQ) { const int w = r / I_SQ, q = r % I_SQ, kb = q >> 5, nb = q & 31;
            const float* W = a.in[w == 0 ? 11 : (w == 1 ? 12 : 13)]; bf16_t* dst = (bf16_t*)(F.ws + (w == 0 ? WS_WBA : (w == 1 ? WS_WBL : WS_WOUT)));
            transpose_item(W, 1024, kb * 64, nb * 32, dst + (size_t)(nb * 32) * 1024, 1024, scr, F.lane); continue; }
        r -= 3 * I_SQ;
        if (r < I_UP) { const int kb = r >> 7, nb = r & 127;
            transpose_item(a.in[16], 4096, kb * 64, nb * 32, (bf16_t*)(F.ws + WS_WUP) + (size_t)(nb * 32) * 1024, 1024, scr, F.lane, a.in[14]); continue; }
        r -= I_UP;
        { const int kb = r >> 5, nb = r & 31;
            transpose_item(a.in[17], 1024, kb * 64, nb * 32, (bf16_t*)(F.ws + WS_WDN) + (size_t)(nb * 32) * 4096, 4096, scr, F.lane); }
    }
    bf16_t* U = (bf16_t*)F.out;
    {
        f32x4 gv[4];
#pragma unroll
        for (int j = 0; j < 4; ++j) gv[j] = ((const f32x4*)a.in[1])[64 * j + F.lane];
        for (int m0 = gw * 4; m0 < T; m0 += NGW * 4) {
            f32x4 v[4][4]; float ss[4];
#pragma unroll
            for (int r = 0; r < 4; ++r) { const f32x4* xr = (const f32x4*)(a.in[0] + (size_t)(m0 + r) * DM) + F.lane; ss[r] = 0.f;
#pragma unroll
                for (int j = 0; j < 4; ++j) v[r][j] = xr[64 * j]; }
#pragma unroll
            for (int r = 0; r < 4; ++r)
#pragma unroll
                for (int j = 0; j < 4; ++j) ss[r] += (v[r][j].x * v[r][j].x + v[r][j].y * v[r][j].y) + (v[r][j].z * v[r][j].z + v[r][j].w * v[r][j].w);
#pragma unroll
            for (int o = 1; o < 64; o <<= 1) {
#pragma unroll
                for (int r = 0; r < 4; ++r) ss[r] += __shfl_xor(ss[r], o); }
#pragma unroll
            for (int r = 0; r < 4; ++r) { const float rs = 1.0f / sqrtf(ss[r] * (1.0f / DM) + NORM_EPS); u32x2* o8 = (u32x2*)(U + (size_t)(m0 + r) * DM) + F.lane;
#pragma unroll
                for (int j = 0; j < 4; ++j) { u32x2 w; w.x = cvt_pk_bf16(v[r][j].x * rs * gv[j].x, v[r][j].y * rs * gv[j].y); w.y = cvt_pk_bf16(v[r][j].z * rs * gv[j].z, v[r][j].w * rs * gv[j].w); o8[64 * j] = w; } }
        }
    }
    const int gt = F.vcu * NTHR + F.tid, NGT = F.G * NTHR;
    float* cosT = (float*)(F.ws + WS_COS); float* sinT = (float*)(F.ws + WS_SIN);
    for (int e = gt; e < SEQ * 16; e += NGT) {
        const int pos = e >> 4, i = e & 15;
        const float inv = powf(500000.0f, -(float)i * (1.0f / 16.0f));
        const float ang = (float)pos * inv;
        double rev = (double)ang * 0.15915494309189535; rev -= rint(rev);
        const float fr = (float)rev;
        cosT[e] = __builtin_amdgcn_cosf(fr); sinT[e] = __builtin_amdgcn_sinf(fr);
    }
    { float* KMz = (float*)(F.ws + WS_KM); for (int e = gt; e < NBH * NBLK * HD; e += NGT) KMz[e] = 0.f; }
    float* c8 = (float*)(F.ws + WS_C8);
    for (int e = gt; e < DM; e += NGT) { const float lam = a.in[10][e]; c8[e] = -8.0f * log1pf(expf(-lam)); }
}

__device__ __forceinline__ void p2_conv_kmean(const Frame& F, const Args& a) {
    const bf16_t* XL = (const bf16_t*)(F.ws + WS_SLOT0 + 3 * SLOT_BYTES); bf16_t* XC = (bf16_t*)F.out;
    const float* cw = a.in[4]; const float* cb = a.in[5];
    {
        const int cg = F.tid & 127, rg = F.tid >> 7, ch = cg * 8;
        float w[4][8], bs[8];
#pragma unroll
        for (int j = 0; j < 4; ++j)
#pragma unroll
            for (int e = 0; e < 8; ++e) w[j][e] = cw[j * DM + ch + e];
#pragma unroll
        for (int e = 0; e < 8; ++e) bs[e] = cb[ch + e];
        for (int un = F.vcu; un < T / 64; un += F.G) {
            const int row0 = un * 64 + rg * 16; const int t0 = row0 & (SEQ - 1);
            u32x4 xr[19];
#pragma unroll
            for (int r = 0; r < 3; ++r) xr[r] = (t0 >= 3) ? *(const u32x4*)(XL + (size_t)(row0 - 3 + r) * DM + ch) : (u32x4){0u, 0u, 0u, 0u};
#pragma unroll
            for (int r = 0; r < 16; ++r) xr[3 + r] = *(const u32x4*)(XL + (size_t)(row0 + r) * DM + ch);
#pragma unroll
            for (int r = 0; r < 16; ++r) {
                const u32x4 p0 = xr[r], p1 = xr[r + 1], p2 = xr[r + 2], p3 = xr[r + 3];
                float o[8];
#pragma unroll
                for (int q = 0; q < 4; ++q) {
                    o[2 * q]     = bs[2 * q]     + w[0][2 * q] * bflo(p0[q])     + w[1][2 * q] * bflo(p1[q])     + w[2][2 * q] * bflo(p2[q])     + w[3][2 * q] * bflo(p3[q]);
                    o[2 * q + 1] = bs[2 * q + 1] + w[0][2 * q + 1] * bfhi(p0[q]) + w[1][2 * q + 1] * bfhi(p1[q]) + w[2][2 * q + 1] * bfhi(p2[q]) + w[3][2 * q + 1] * bfhi(p3[q]);
                }
                u32x4 ww; ww.x = cvt_pk_bf16(o[0], o[1]); ww.y = cvt_pk_bf16(o[2], o[3]); ww.z = cvt_pk_bf16(o[4], o[5]); ww.w = cvt_pk_bf16(o[6], o[7]);
                *(u32x4*)(XC + (size_t)(row0 + r) * DM + ch) = ww;
            }
        }
    }
    {
        const float* KM = (const float*)(F.ws + WS_KM);
        for (int e = F.vcu * NTHR + F.tid; e < NBH * NBLK * HD; e += F.G * NTHR) {
            const float km = KM[e];
            const unsigned hb = f2bf(km); const float hf = __uint_as_float(hb << 16);
            ((bf16_t*)(F.ws + WS_KMH))[e] = (bf16_t)hb; ((bf16_t*)(F.ws + WS_KML))[e] = (bf16_t)f2bf(km - hf);
        }
    }
}

__device__ __forceinline__ void top3_insert_idx(float v, int n, float& v0, float& v1, float& v2, int& i0, int& i1, int& i2) {
    const bool g0 = (v > v0) || (v == v0 && n < i0), g1 = (v > v1) || (v == v1 && n < i1), g2 = (v > v2) || (v == v2 && n < i2);
    const float nv2 = g1 ? v1 : (g2 ? v : v2); const int ni2 = g1 ? i1 : (g2 ? n : i2);
    const float nv1 = g0 ? v0 : (g1 ? v : v1); const int ni1 = g0 ? i0 : (g1 ? n : i1);
    const float nv0 = g0 ? v : v0;             const int ni0 = g0 ? n : i0;
    v0 = nv0; v1 = nv1; v2 = nv2; i0 = ni0; i1 = ni1; i2 = ni2;
}
__device__ __forceinline__ void p3_select(const Frame& F) {
    const bf16_t* Q = (const bf16_t*)(F.ws + WS_SLOT0); const bf16_t* KMH = (const bf16_t*)(F.ws + WS_KMH); const bf16_t* KML = (const bf16_t*)(F.ws + WS_KML);
    int* CNT = (int*)(F.ws + WS_CNT); bf16_t* LIST = (bf16_t*)(F.ws + WS_LIST);
    int* cnt = (int*)F.lds;
    const int c = F.lane & 31, hh = F.lane >> 5;
    for (int un = F.vcu * 4; un < F.vcu * 4 + 4 && un < NBH * NBLK; ++un) {
        const int bh = un >> 5, j = un & 31, b = bh >> 3, h = bh & 7;
        __syncthreads();
        if (F.tid < 32) cnt[F.tid] = 0;
        __syncthreads();
        const int q = 32 * F.wave + c;
        const bf16_t* qp = Q + (size_t)(b * SEQ + j * 256 + q) * DM + h * HD + 8 * hh;
        const bf16_t* kh = KMH + ((size_t)bh * 32 + c) * 128 + 8 * hh; const bf16_t* kl = KML + ((size_t)bh * 32 + c) * 128 + 8 * hh;
        bf16x8 qf[8], ah[8], al[8];
#pragma unroll
        for (int s2 = 0; s2 < 8; ++s2) { qf[s2] = *(const bf16x8*)(qp + 16 * s2); ah[s2] = *(const bf16x8*)(kh + 16 * s2); al[s2] = *(const bf16x8*)(kl + 16 * s2); }
        f32x16 gt;
#pragma unroll
        for (int i = 0; i < 16; ++i) gt[i] = 0.f;
#pragma unroll
        for (int s2 = 0; s2 < 8; ++s2) { gt = __builtin_amdgcn_mfma_f32_32x32x16_bf16(al[s2], qf[s2], gt, 0, 0, 0); gt = __builtin_amdgcn_mfma_f32_32x32x16_bf16(ah[s2], qf[s2], gt, 0, 0, 0); }
        float v0 = -INFINITY, v1 = -INFINITY, v2 = -INFINITY; int i0 = 64, i1 = 64, i2 = 64;
#pragma unroll
        for (int i = 0; i < 16; ++i) { const int n = (i & 3) + 8 * (i >> 2) + 4 * hh; const float v = (n < j) ? gt[i] : -INFINITY; top3_insert_idx(v, n, v0, v1, v2, i0, i1, i2); }
        {
            const float w0 = __shfl_xor(v0, 32), w1 = __shfl_xor(v1, 32), w2 = __shfl_xor(v2, 32);
            const int k0 = __shfl_xor(i0, 32), k1 = __shfl_xor(i1, 32), k2 = __shfl_xor(i2, 32);
            top3_insert_idx(w0, k0, v0, v1, v2, i0, i1, i2); top3_insert_idx(w1, k1, v0, v1, v2, i0, i1, i2); top3_insert_idx(w2, k2, v0, v1, v2, i0, i1, i2);
        }
        if (hh == 0) {
            const int nr = j < 3 ? j : 3;
            if (0 < nr) { const int pos = atomicAdd(&cnt[i0], 1); LIST[((size_t)(bh * 32 + i0) * 32 + j) * 256 + pos] = (bf16_t)(q | (0 << 8)); }
            if (1 < nr) { const int pos = atomicAdd(&cnt[i1], 1); LIST[((size_t)(bh * 32 + i1) * 32 + j) * 256 + pos] = (bf16_t)(q | (1 << 8)); }
            if (2 < nr) { const int pos = atomicAdd(&cnt[i2], 1); LIST[((size_t)(bh * 32 + i2) * 32 + j) * 256 + pos] = (bf16_t)(q | (2 << 8)); }
        }
        __syncthreads();
        if (F.tid < 32) CNT[(bh * 32 + F.tid) * 32 + j] = cnt[F.tid];
    }
    __syncthreads();
}

template <int PASS> __device__ __forceinline__ void p45_scan(const Frame& F) {
    const bf16_t* LA = (const bf16_t*)((unsigned char*)F.out + SLOT_BYTES); const bf16_t* BX = (const bf16_t*)(F.ws + WS_SLOT0 + 3 * SLOT_BYTES);
    bf16_t* G = (bf16_t*)(F.ws + WS_SLOT0 + 4 * SLOT_BYTES);
    float* SLA = (float*)(F.ws + WS_SUMLA); float* SH = (float*)(F.ws + WS_SUMH);
    const int ch = F.tid * 2;
    for (int un = F.vcu; un < BATCH * 64; un += F.G) {
        const int b = un >> 6, c = un & 63;
        const size_t base = (size_t)(b * SEQ + c * 128) * DM + ch;
        float h0 = 0.f, h1 = 0.f, sl0 = 0.f, sl1 = 0.f;
        if (PASS == 2) {
            for (int c0 = 0; c0 < c; c0 += 8) {
                float2 la[8], hv[8];
#pragma unroll
                for (int q = 0; q < 8; ++q) { const int cc = (c0 + q < c) ? c0 + q : c - 1; const size_t so = (size_t)(b * 64 + cc) * DM + ch; la[q] = *(const float2*)(SLA + so); hv[q] = *(const float2*)(SH + so); }
#pragma unroll
                for (int q = 0; q < 8; ++q) if (c0 + q < c) { h0 = __expf(la[q].x) * h0 + hv[q].x; h1 = __expf(la[q].y) * h1 + hv[q].y; }
            }
        }
        for (int r0 = 0; r0 < 128; r0 += 16) {
            unsigned lw[16], bw[16], gw[16];
#pragma unroll
            for (int r = 0; r < 16; ++r) { lw[r] = *(const unsigned*)(LA + base + (size_t)(r0 + r) * DM); bw[r] = *(const unsigned*)(BX + base + (size_t)(r0 + r) * DM);
                if (PASS == 2) gw[r] = *(const unsigned*)(G + base + (size_t)(r0 + r) * DM); }
            unsigned hv[16];
#pragma unroll
            for (int r = 0; r < 16; ++r) {
                const float l0 = bflo(lw[r]), l1 = bfhi(lw[r]);
                const float a0 = __expf(l0), a1 = __expf(l1);
                h0 = a0 * h0 + __builtin_amdgcn_sqrtf(fmaxf(1.0f - a0 * a0, 0.f)) * bflo(bw[r]); h1 = a1 * h1 + __builtin_amdgcn_sqrtf(fmaxf(1.0f - a1 * a1, 0.f)) * bfhi(bw[r]);
                if (PASS == 1) { sl0 += l0; sl1 += l1; }
                if (PASS == 2) hv[r] = cvt_pk_bf16(h0 * gelu_tanh(bflo(gw[r])), h1 * gelu_tanh(bfhi(gw[r])));
            }
            if (PASS == 2) {
#pragma unroll
                for (int r = 0; r < 16; ++r) { if (!F.dummy) *(unsigned*)(G + base + (size_t)(r0 + r) * DM) = hv[r]; else asm volatile("" :: "v"(hv[r])); }
            }
        }
        if (PASS == 1) { const size_t so = (size_t)un * DM + ch; *(float2*)(SLA + so) = make_float2(sl0, sl1); *(float2*)(SH + so) = make_float2(h0, h1); }
    }
}

constexpr int AT_KS = 0, AT_KROW = 272;
constexpr int AT_VS = 256 * AT_KROW, AT_VROW = 520;
constexpr int AT_ROWS = AT_VS + 128 * AT_VROW;
constexpr int AT_WSF = AT_ROWS + 1024;
constexpr int AT_MISC = AT_WSF + 4096;
static_assert(AT_MISC + 4096 + 1024 <= LDS_BYTES, "attention LDS map");
constexpr float SM_SCALE = 0.08838834764831845f;
constexpr float SM_C = SM_SCALE * 1.4426950408889634f;

__device__ __forceinline__ void attn_load_kv(const Frame& F, int bh, int n) {
    const int b = bh >> 3, h = bh & 7;
    const bf16_t* K = (const bf16_t*)(F.ws + WS_SLOT0 + 1 * SLOT_BYTES); const bf16_t* VT = (const bf16_t*)(F.ws + WS_SLOT0 + 2 * SLOT_BYTES);
    const size_t tok0 = (size_t)b * SEQ + n * 256;
#pragma unroll
    for (int p = 0; p < 8; ++p) { const int idx = p * 512 + F.tid, row = idx >> 4, c16 = idx & 15;
        const u32x4 v = *(const u32x4*)(K + (tok0 + row) * DM + h * HD + c16 * 8);
        *(u32x4*)(F.lds + AT_KS + row * AT_KROW + c16 * 16) = v; }
#pragma unroll
    for (int p = 0; p < 8; ++p) { const int idx = p * 512 + F.tid, d = idx >> 5, c16 = idx & 31;
        const u32x4 v = *(const u32x4*)(VT + (size_t)(h * HD + d) * T + tok0 + c16 * 8);
        u32x2* dst = (u32x2*)(F.lds + AT_VS + d * AT_VROW + c16 * 16); dst[0] = (u32x2){v.x, v.y}; dst[1] = (u32x2){v.z, v.w}; }
}

__device__ __forceinline__ float xhalf_max(float v) { auto rr = __builtin_amdgcn_permlane32_swap(__float_as_uint(v), __float_as_uint(v), false, false); return fmaxf(__uint_as_float(rr[0]), __uint_as_float(rr[1])); }
__device__ __forceinline__ float xhalf_sum(float v) { auto rr = __builtin_amdgcn_permlane32_swap(__float_as_uint(v), __float_as_uint(v), false, false); return __uint_as_float(rr[0]) + __uint_as_float(rr[1]); }
template <int MODE> __device__ __forceinline__ void attn_subtile(const Frame& F, int h, unsigned tok, bool valid, unsigned rank, int rb, int jblk, const bf16x8 (&qf)[8], const bf16_t* qnp, bf16x8 (&qn)[8]) {
    const int lane = F.lane, c = lane & 31, hh = lane >> 5;
    bf16_t* Q = (bf16_t*)(F.ws + WS_SLOT0);
    float* LSE = (float*)(F.ws + WS_LSE);
    bf16_t* P0 = (bf16_t*)F.out; bf16_t* P1 = (bf16_t*)((unsigned char*)F.out + SLOT_BYTES); bf16_t* P2 = (bf16_t*)(F.ws + WS_SLOT0 + 3 * SLOT_BYTES);
    if (qnp) {
#pragma unroll
        for (int s = 0; s < 8; ++s) qn[s] = *(const bf16x8*)(qnp + 16 * s);
    }
    const int ng = (MODE == 1) ? (rb + 1) : 8;
    f32x16 o[4];
#pragma unroll
    for (int dg = 0; dg < 4; ++dg) {
#pragma unroll
        for (int i = 0; i < 16; ++i) o[dg][i] = 0.f;
    }
    float mx = -INFINITY, ls = 0.f;
    const int qlim = c - 4 * hh;
    const unsigned char* kbase = F.lds + AT_KS + c * AT_KROW + 16 * hh;
    const unsigned char* vbase = F.lds + AT_VS + c * AT_VROW + 8 * hh;
    for (int g = 0; g < ng; ++g) {
        f32x16 st;
#pragma unroll
        for (int i = 0; i < 16; ++i) st[i] = 0.f;
        { const unsigned char* kp = kbase + (32 * g) * AT_KROW;
          bf16x8 kf[8];
#pragma unroll
          for (int s = 0; s < 8; ++s) kf[s] = *(const bf16x8*)(kp + 32 * s);
          __builtin_amdgcn_sched_barrier(0);
#pragma unroll
          for (int s = 0; s < 8; ++s) st = __builtin_amdgcn_mfma_f32_32x32x16_bf16(kf[s], qf[s], st, 0, 0, 0);
        }
        if (MODE == 1 && g == rb) {
#pragma unroll
            for (int i = 0; i < 16; ++i) { const int msk = (qlim - ((i & 3) + 8 * (i >> 2))) >> 31;
                st[i] = fminf(st[i], __uint_as_float(0x7f800000u | ((unsigned)msk & 0x80000000u))); }
        }
        float ml = st[0];
#pragma unroll
        for (int i = 1; i < 16; ++i) ml = fmaxf(ml, st[i]);
        ml = xhalf_max(ml);
        const float mn = fmaxf(mx, ml);
        const float alpha = __builtin_amdgcn_exp2f((mx - mn) * SM_C);
        const float nb = -mn * SM_C;
        float ps = 0.f;
#pragma unroll
        for (int i = 0; i < 16; ++i) { st[i] = __builtin_amdgcn_exp2f(fmaf(st[i], SM_C, nb)); ps += st[i]; }
        ls = ls * alpha + ps;
        if (!__all(mn == mx)) {
#pragma unroll
            for (int dg = 0; dg < 4; ++dg)
#pragma unroll
                for (int i = 0; i < 16; ++i) o[dg][i] *= alpha;
        }
        mx = mn;
        bf16x8 pf[2];
#pragma unroll
        for (int s2 = 0; s2 < 2; ++s2) { u32x4 pw; pw.x = cvt_pk_bf16(st[8 * s2], st[8 * s2 + 1]); pw.y = cvt_pk_bf16(st[8 * s2 + 2], st[8 * s2 + 3]); pw.z = cvt_pk_bf16(st[8 * s2 + 4], st[8 * s2 + 5]); pw.w = cvt_pk_bf16(st[8 * s2 + 6], st[8 * s2 + 7]);
            pf[s2] = __builtin_bit_cast(bf16x8, pw); }
        const unsigned char* vp0 = vbase + (32 * g) * 2;
#pragma unroll
        for (int s2 = 0; s2 < 2; ++s2) {
            bf16x8 vf[4];
#pragma unroll
            for (int dg = 0; dg < 4; ++dg) { const unsigned char* vp = vp0 + (32 * dg) * AT_VROW + 32 * s2;
                const bf16x4 lo = *(const bf16x4*)vp, hi = *(const bf16x4*)(vp + 16);
                vf[dg] = (bf16x8){lo[0], lo[1], lo[2], lo[3], hi[0], hi[1], hi[2], hi[3]}; }
#pragma unroll
            for (int dg = 0; dg < 4; ++dg) o[dg] = __builtin_amdgcn_mfma_f32_32x32x16_bf16(vf[dg], pf[s2], o[dg], 0, 0, 0);
        }
    }
    ls = xhalf_sum(ls);
    const float lse_own = mx * SM_SCALE + __logf(ls);
    const size_t obase = (size_t)tok * DM + h * HD + 4 * hh;
    if (MODE == 0) {
        if (valid) {
            const float li = __builtin_amdgcn_rcpf(ls);
            if (hh == 0) LSE[((size_t)rank * T + tok) * NH + h] = lse_own;
            bf16_t* pp = (rank == 0 ? P0 : (rank == 1 ? P1 : P2)) + obase;
#pragma unroll
            for (int dg = 0; dg < 4; ++dg)
#pragma unroll
                for (int q = 0; q < 4; ++q) { u32x2 w; w.x = cvt_pk_bf16(o[dg][4 * q] * li, o[dg][4 * q + 1] * li); w.y = cvt_pk_bf16(o[dg][4 * q + 2] * li, o[dg][4 * q + 3] * li);
                    *(u32x2*)(pp + 32 * dg + 8 * q) = w; }
        }
    } else {
        const int nr = jblk < 3 ? jblk : 3;
        float l0 = -INFINITY, l1 = -INFINITY, l2 = -INFINITY;
        if (0 < nr) l0 = LSE[((size_t)0 * T + tok) * NH + h];
        if (1 < nr) l1 = LSE[((size_t)1 * T + tok) * NH + h];
        if (2 < nr) l2 = LSE[((size_t)2 * T + tok) * NH + h];
        const float M = fmaxf(fmaxf(lse_own, l0), fmaxf(l1, l2));
        const float wo = __expf(lse_own - M), w0 = __expf(l0 - M), w1 = __expf(l1 - M), w2 = __expf(l2 - M);
        const float inv = __builtin_amdgcn_rcpf(wo + w0 + w1 + w2);
        const float ao = wo * inv * __builtin_amdgcn_rcpf(ls), a0 = w0 * inv, a1 = w1 * inv, a2 = w2 * inv;
#pragma unroll
        for (int dg = 0; dg < 4; ++dg)
#pragma unroll
            for (int i = 0; i < 16; ++i) o[dg][i] *= ao;
#define ATT_ADD_PLANE(PP, AW) do { u32x2 pl[16]; \
        _Pragma("unroll") for (int t = 0; t < 16; ++t) pl[t] = *(const u32x2*)((PP) + obase + 32 * (t >> 2) + 8 * (t & 3)); \
        _Pragma("unroll") for (int t = 0; t < 16; ++t) { const int dg = t >> 2, q = t & 3; \
            o[dg][4 * q] += (AW) * bflo(pl[t].x); o[dg][4 * q + 1] += (AW) * bfhi(pl[t].x); o[dg][4 * q + 2] += (AW) * bflo(pl[t].y); o[dg][4 * q + 3] += (AW) * bfhi(pl[t].y); } } while (0)
        if (0 < nr) ATT_ADD_PLANE(P0, a0);
        if (1 < nr) ATT_ADD_PLANE(P1, a1);
        if (2 < nr) ATT_ADD_PLANE(P2, a2);
#undef ATT_ADD_PLANE
#pragma unroll
        for (int t = 0; t < 16; ++t) {
            const int dg = t >> 2, q = t & 3;
            u32x2 w; w.x = cvt_pk_bf16(o[dg][4 * q], o[dg][4 * q + 1]); w.y = cvt_pk_bf16(o[dg][4 * q + 2], o[dg][4 * q + 3]);
            if (!F.dummy) *(u32x2*)(Q + obase + 32 * dg + 8 * q) = w; else asm volatile("" :: "v"(w.x), "v"(w.y));
        }
    }
}

__device__ __forceinline__ void p6_attn_sel(const Frame& F) {
    const int* CNT = (const int*)(F.ws + WS_CNT); const bf16_t* LIST = (const bf16_t*)(F.ws + WS_LIST);
    const bf16_t* Q = (const bf16_t*)(F.ws + WS_SLOT0);
    int* pre = (int*)(F.lds + AT_MISC);
    int* wt = pre + 1032;
    int* seg = pre + 1048;
    const int c = F.lane & 31, hh = F.lane >> 5;
    constexpr int BKT_OVH = 8;
    int t0, t1;
    { int R0 = 0, R1 = 0; const int b0 = 2 * F.tid, b1 = b0 + 1, n0 = b0 & 31, n1 = b1 & 31;
      const int4* r0 = (const int4*)(CNT + b0 * 32); const int4* r1 = (const int4*)(CNT + b1 * 32);
      int4 v0[8], v1[8];
#pragma unroll
      for (int q = 0; q < 8; ++q) { v0[q] = r0[q]; v1[q] = r1[q]; }
#pragma unroll
      for (int q = 0; q < 8; ++q) {
          R0 += (4 * q > n0 ? v0[q].x : 0) + (4 * q + 1 > n0 ? v0[q].y : 0) + (4 * q + 2 > n0 ? v0[q].z : 0) + (4 * q + 3 > n0 ? v0[q].w : 0);
          R1 += (4 * q > n1 ? v1[q].x : 0) + (4 * q + 1 > n1 ? v1[q].y : 0) + (4 * q + 2 > n1 ? v1[q].z : 0) + (4 * q + 3 > n1 ? v1[q].w : 0); }
      t0 = R0 > 0 ? ((R0 + 31) >> 5) + BKT_OVH : 0; t1 = R1 > 0 ? ((R1 + 31) >> 5) + BKT_OVH : 0; }
    int s = t0 + t1, incl = s;
#pragma unroll
    for (int o = 1; o < 64; o <<= 1) { const int v = __shfl_up(incl, o); if (F.lane >= o) incl += v; }
    if (F.lane == 63) wt[F.wave] = incl;
    __syncthreads();
    int woff = 0;
    for (int ww = 0; ww < F.wave; ++ww) woff += wt[ww];
    pre[2 * F.tid] = woff + incl - s; pre[2 * F.tid + 1] = woff + incl - s + t0;
    if (F.tid == 511) pre[1024] = woff + incl;
    __syncthreads();
    const int total = pre[1024];
    const int sbeg = (int)((long)F.vcu * total / F.G), send = (int)((long)(F.vcu + 1) * total / F.G);
    int cpos = sbeg;
    while (cpos < send) {
        int lo = 0, hi = 1023;
        while (lo < hi) { const int mid = (lo + hi + 1) >> 1; if (pre[mid] <= cpos) lo = mid; else hi = mid - 1; }
        const int bk = lo, bh = bk >> 5, n = bk & 31, b = bh >> 3, h = bh & 7;
        const int first = pre[bk] + BKT_OVH;
        const int cs = max(cpos, first), bend = min(send, pre[bk + 1]);
        cpos = pre[bk + 1] < send ? pre[bk + 1] : send;
        if (cs >= bend) continue;
        __syncthreads();
        attn_load_kv(F, bh, n);
        if (F.tid < 64) { int a = (F.tid > n && F.tid < 32) ? CNT[bk * 32 + F.tid] : 0;
#pragma unroll
            for (int o = 1; o < 32; o <<= 1) { const int v = __shfl_up(a, o); if (F.lane >= o) a += v; }
            if (F.tid < 32) seg[F.tid] = a; }
        __syncthreads();
        const int R = seg[31];
        auto rowinfo = [&](int st) -> unsigned {
            int grow = 32 * (st - first) + c; const bool v = grow < R; grow = v ? grow : R - 1;
            int jj = n + 1;
            for (int t = n + 1; t < 31; ++t) jj += (seg[t] <= grow) ? 1 : 0;
            const unsigned e = LIST[((size_t)bk * 32 + jj) * 256 + (grow - seg[jj - 1])];
            return (unsigned)(b * SEQ + jj * 256 + (e & 255u)) | ((e >> 8) << 20) | (v ? 0x80000000u : 0u);
        };
        int st = cs + F.wave;
        if (st < bend) {
            unsigned info = rowinfo(st);
            bf16x8 qa[8], qb[8];
            { const bf16_t* qp = Q + (size_t)(info & 0xfffffu) * DM + h * HD + 8 * hh;
#pragma unroll
              for (int s2 = 0; s2 < 8; ++s2) qa[s2] = *(const bf16x8*)(qp + 16 * s2); }
            for (;;) {
                const int st1 = st + NWAVE; const bool h1 = st1 < bend;
                unsigned info1 = h1 ? rowinfo(st1) : 0u;
                attn_subtile<0>(F, h, info & 0xfffffu, (info >> 31) != 0u, (info >> 20) & 3u, 0, 0, qa, h1 ? Q + (size_t)(info1 & 0xfffffu) * DM + h * HD + 8 * hh : nullptr, qb);
                if (!h1) break;
                const int st2 = st1 + NWAVE; const bool h2 = st2 < bend;
                info = h2 ? rowinfo(st2) : 0u;
                attn_subtile<0>(F, h, info1 & 0xfffffu, (info1 >> 31) != 0u, (info1 >> 20) & 3u, 0, 0, qb, h2 ? Q + (size_t)(info & 0xfffffu) * DM + h * HD + 8 * hh : nullptr, qa);
                if (!h2) break;
                st = st2;
            }
        }
    }
    __syncthreads();
}
__device__ __forceinline__ void p7_attn_own(const Frame& F) {
    const bf16_t* Q = (const bf16_t*)(F.ws + WS_SLOT0);
    const int c = F.lane & 31, hh = F.lane >> 5;
    const int u0 = F.vcu * 4;
    bf16x8 qa[8], qb[8];
    { const int bh = u0 >> 5, j = u0 & 31; const bf16_t* qp = Q + (size_t)((bh >> 3) * SEQ + j * 256 + 32 * F.wave + c) * DM + (bh & 7) * HD + 8 * hh;
#pragma unroll
      for (int s2 = 0; s2 < 8; ++s2) qa[s2] = *(const bf16x8*)(qp + 16 * s2); }
#pragma unroll
    for (int k = 0; k < 4; ++k) {
        const int un = u0 + k, bh = un >> 5, j = un & 31, b = bh >> 3, h = bh & 7;
        const int un1 = un + 1, bh1 = un1 >> 5, j1 = un1 & 31;
        const bf16_t* qnp = (k < 3) ? Q + (size_t)((bh1 >> 3) * SEQ + j1 * 256 + 32 * F.wave + c) * DM + (bh1 & 7) * HD + 8 * hh : nullptr;
        __syncthreads();
        attn_load_kv(F, bh, j);
        __syncthreads();
        if (k & 1) attn_subtile<1>(F, h, (unsigned)(b * SEQ + j * 256 + 32 * F.wave + c), true, 0u, F.wave, j, qb, qnp, qa);
        else       attn_subtile<1>(F, h, (unsigned)(b * SEQ + j * 256 + 32 * F.wave + c), true, 0u, F.wave, j, qa, qnp, qb);
    }
    __syncthreads();
}

__device__ __forceinline__ void p10_norm_mid(const Frame& F, const Args& a) {
    const bf16_t* MIX = (const bf16_t*)(F.ws + WS_SLOT0 + 2 * SLOT_BYTES); bf16_t* H1 = (bf16_t*)(F.ws + WS_SLOT0); float* RS2 = (float*)(F.ws + WS_RS2);
    const float* g2 = a.in[2];
    const int gw = F.vcu * NWAVE + F.wave, NGW = F.G * NWAVE;
    f32x4 gv[4];
#pragma unroll
    for (int j = 0; j < 4; ++j) gv[j] = ((const f32x4*)g2)[64 * j + F.lane];
    for (int m0 = gw * 4; m0 < T; m0 += NGW * 4) {
        f32x4 v[4][4], xv[4][4]; float s[4];
#pragma unroll
        for (int r = 0; r < 4; ++r) { const u32x2* mr = (const u32x2*)(MIX + (size_t)(m0 + r) * DM) + F.lane; const f32x4* xr = (const f32x4*)(a.in[0] + (size_t)(m0 + r) * DM) + F.lane; s[r] = 0.f;
#pragma unroll
            for (int j = 0; j < 4; ++j) { const u32x2 w = mr[64 * j]; xv[r][j] = xr[64 * j]; v[r][j] = (f32x4){bflo(w.x), bfhi(w.x), bflo(w.y), bfhi(w.y)}; } }
#pragma unroll
        for (int r = 0; r < 4; ++r)
#pragma unroll
            for (int j = 0; j < 4; ++j) s[r] += (v[r][j].x * v[r][j].x + v[r][j].y * v[r][j].y) + (v[r][j].z * v[r][j].z + v[r][j].w * v[r][j].w);
#pragma unroll
        for (int o = 1; o < 64; o <<= 1) {
#pragma unroll
            for (int r = 0; r < 4; ++r) s[r] += __shfl_xor(s[r], o); }
        float s2[4];
#pragma unroll
        for (int r = 0; r < 4; ++r) { const float rs = 1.0f / sqrtf(s[r] * (1.0f / DM) + NORM_EPS); s2[r] = 0.f;
            u32x2* o8 = (u32x2*)(H1 + (size_t)(m0 + r) * DM) + F.lane;
#pragma unroll
            for (int j = 0; j < 4; ++j) { const f32x4 h = xv[r][j] + v[r][j] * rs * gv[j]; s2[r] += (h.x * h.x + h.y * h.y) + (h.z * h.z + h.w * h.w);
                u32x2 w; w.x = cvt_pk_bf16(h.x, h.y); w.y = cvt_pk_bf16(h.z, h.w); o8[64 * j] = w; } }
#pragma unroll
        for (int o = 1; o < 64; o <<= 1) {
#pragma unroll
            for (int r = 0; r < 4; ++r) s2[r] += __shfl_xor(s2[r], o); }
        if (F.lane < 4) { const float sv = F.lane == 0 ? s2[0] : (F.lane == 1 ? s2[1] : (F.lane == 2 ? s2[2] : s2[3])); RS2[m0 + F.lane] = 1.0f / sqrtf(sv * (1.0f / DM) + NORM_EPS); }
    }
}
__device__ __forceinline__ void p13_norm_final(const Frame& F, const Args& a) {
    const bf16_t* MD = (const bf16_t*)(F.ws + WS_SLOT0 + 1 * SLOT_BYTES); const bf16_t* H1 = (const bf16_t*)(F.ws + WS_SLOT0); const float* g4 = a.in[15];
    const int gw = F.vcu * NWAVE + F.wave, NGW = F.G * NWAVE;
    f32x4 gv[4];
#pragma unroll
    for (int j = 0; j < 4; ++j) gv[j] = ((const f32x4*)g4)[64 * j + F.lane];
    for (int m0 = gw * 4; m0 < T; m0 += NGW * 4) {
        u32x2 mw[4][4], hw[4][4]; float s[4];
#pragma unroll
        for (int r = 0; r < 4; ++r) { const u32x2* mr = (const u32x2*)(MD + (size_t)(m0 + r) * DM) + F.lane; const u32x2* hr = (const u32x2*)(H1 + (size_t)(m0 + r) * DM) + F.lane; s[r] = 0.f;
#pragma unroll
            for (int j = 0; j < 4; ++j) { mw[r][j] = mr[64 * j]; hw[r][j] = hr[64 * j]; } }
#pragma unroll
        for (int r = 0; r < 4; ++r)
#pragma unroll
            for (int j = 0; j < 4; ++j) { const float a0 = bflo(mw[r][j].x), a1 = bfhi(mw[r][j].x), a2 = bflo(mw[r][j].y), a3 = bfhi(mw[r][j].y); s[r] += (a0 * a0 + a1 * a1) + (a2 * a2 + a3 * a3); }
#pragma unroll
        for (int o = 1; o < 64; o <<= 1) {
#pragma unroll
            for (int r = 0; r < 4; ++r) s[r] += __shfl_xor(s[r], o); }
#pragma unroll
        for (int r = 0; r < 4; ++r) { const float rs = 1.0f / sqrtf(s[r] * (1.0f / DM) + NORM_EPS); f32x4* orow = (f32x4*)(F.out + (size_t)(m0 + r) * DM) + F.lane;
#pragma unroll
            for (int j = 0; j < 4; ++j) { const f32x4 mv = (f32x4){bflo(mw[r][j].x), bfhi(mw[r][j].x), bflo(mw[r][j].y), bfhi(mw[r][j].y)}; const f32x4 hv = (f32x4){bflo(hw[r][j].x), bfhi(hw[r][j].x), bflo(hw[r][j].y), bfhi(hw[r][j].y)};
                orow[64 * j] = hv + mv * rs * gv[j]; } }
    }
}

#define XB_TMO      128
#define XB_XCNT(j)  (256  + 64 * (j))
#define XB_XSUB(j)  (1280 + 64 * (j))
#define XB_XGEN(j)  (2304 + 64 * (j))
#define XB_TOP      3328
#define XB_TOPGEN   3392
#define XCD_BAR_WORDS 3456
#define XB_SPIN_CAP (1u << 22)
__device__ __forceinline__ unsigned xb_ld(unsigned* p)              { return __hip_atomic_load(p, __ATOMIC_RELAXED, __HIP_MEMORY_SCOPE_AGENT); }
__device__ __forceinline__ unsigned xb_add(unsigned* p, unsigned v) { return __hip_atomic_fetch_add(p, v, __ATOMIC_RELAXED, __HIP_MEMORY_SCOPE_AGENT); }
__device__ __forceinline__ unsigned xb_xcc_id() { return (unsigned)__builtin_amdgcn_s_getreg((3 << 11) | 20) & 0xFu; }
#define XB_SPIN(cond, bar) do { unsigned _sp = 0; while (cond) { __builtin_amdgcn_s_sleep(1); \
    if ((++_sp & 255u) == 0u) { if (xb_ld(&(bar)[XB_TMO])) break; if (_sp > XB_SPIN_CAP) { atomicAdd(&(bar)[XB_TMO], 1u); break; } } } } while (0)
struct XcdBarrier { unsigned* bar; unsigned x; volatile unsigned* st; };
__device__ __forceinline__ XcdBarrier xcd_barrier_post(unsigned* bar, volatile unsigned* st) {
    XcdBarrier b; b.bar = bar; b.x = xb_xcc_id(); b.st = st;
    if (threadIdx.x == 0) (void)xb_add(&bar[XB_XCNT(b.x)], 1u);
    return b;
}
__device__ __forceinline__ void xcd_barrier_complete(unsigned* bar, unsigned x, unsigned& nloc, unsigned& nx) {
    const unsigned G = gridDim.x * gridDim.y * gridDim.z;
    unsigned sum, cnt, mine, sp = 0u;
    for (;;) {
        sum = 0u; cnt = 0u; mine = 0u;
#pragma unroll
        for (unsigned j = 0; j < 16; ++j) { const unsigned c = xb_ld(&bar[XB_XCNT(j)]); sum += c; cnt += (c > 0u) ? 1u : 0u; mine = (j == x) ? c : mine; }
        if (sum == G) break;
        __builtin_amdgcn_s_sleep(1);
        if ((++sp & 255u) == 0u) { if (xb_ld(&bar[XB_TMO])) break; if (sp > XB_SPIN_CAP) { atomicAdd(&bar[XB_TMO], 1u); break; } }
    }
    nloc = mine > 0u ? mine : 1u; nx = cnt > 0u ? cnt : 1u;
}
__device__ __forceinline__ void xcd_barrier(const XcdBarrier& b) {
    asm volatile("s_waitcnt vmcnt(0)" ::: "memory");
    __syncthreads();
    if (threadIdx.x == 0) {
        unsigned* bar = b.bar;
        __builtin_amdgcn_s_waitcnt(0);
        unsigned nloc = b.st[0], nx = b.st[1];
        if (nloc == 0u) { xcd_barrier_complete(bar, b.x, nloc, nx); b.st[0] = nloc; b.st[1] = nx; }
        const unsigned old = xb_add(&bar[XB_XSUB(b.x)], 1u);
        const unsigned gen = old / nloc;
        if (old + 1u == (gen + 1u) * nloc) {
            __builtin_amdgcn_fence(__ATOMIC_RELEASE, "agent");
            asm volatile("s_waitcnt vmcnt(0)" ::: "memory");
            const unsigned og = xb_add(&bar[XB_TOP], 1u);
            const unsigned tg = og / nx;
            if (og + 1u == (tg + 1u) * nx) xb_add(&bar[XB_TOPGEN], 1u);
            else XB_SPIN(xb_ld(&bar[XB_TOPGEN]) == tg, bar);
            __builtin_amdgcn_fence(__ATOMIC_ACQUIRE, "agent");
            xb_add(&bar[XB_XGEN(b.x)], 1u);
            asm volatile("s_waitcnt vmcnt(0)" ::: "memory");
        } else {
            XB_SPIN(xb_ld(&bar[XB_XGEN(b.x)]) == gen, bar);
            __builtin_amdgcn_fence(__ATOMIC_ACQUIRE, "agent");
            asm volatile("s_waitcnt vmcnt(0)" ::: "memory");
        }
    }
    __syncthreads();
}

#ifndef GEMM_BODY
#define GEMM_BODY gemm_fast
#endif

__global__ void __launch_bounds__(NTHR, 2) fwd_kernel(Args args) {
    extern __shared__ __attribute__((aligned(16))) unsigned char lds[];
    Frame F;
    F.lds = lds; F.tid = threadIdx.x; F.lane = F.tid & 63; F.wave = __builtin_amdgcn_readfirstlane(F.tid >> 6);
    F.G = gridDim.x; { const int bx = blockIdx.x; F.vcu = (F.G % 8 == 0) ? (bx % 8) * (F.G / 8) + bx / 8 : bx; }
    F.ws = args.ws; F.out = args.out; F.dummy = 0;
    unsigned char* ws = args.ws;
    bf16_t* S0 = (bf16_t*)(ws + WS_SLOT0);
#define SL(i) ((bf16_t*)(ws + WS_SLOT0 + (size_t)(i) * SLOT_BYTES))
    const float* cosT = (const float*)(ws + WS_COS); const float* sinT = (const float*)(ws + WS_SIN);
    const int lo = args.ph_lo, hi = args.ph_hi;
    volatile unsigned* bst = (volatile unsigned*)(lds + LDS_BYTES - 64);
    if (F.tid < 16) ((volatile unsigned*)(lds + LDS_BYTES - 64))[F.tid] = 0u;
    __syncthreads();
    XcdBarrier bar; bar.bar = (unsigned*)(ws + WS_CTL) + 1024; bar.x = 0; bar.st = bst;
    if (hi - lo > 1) bar = xcd_barrier_post((unsigned*)(ws + WS_CTL) + 1024, bst);
#define IN(k) (lo <= (k) && (k) < hi && (refresh(F), true))
#define SEAM(k) do { if ((k) + 1 < hi) xcd_barrier(bar); } while (0)

#define TSTAMP(i) do { if (blockIdx.x == 0 && threadIdx.x == 0) ((volatile unsigned long long*)(lds + LDS_BYTES - 32))[i] = __builtin_amdgcn_s_memrealtime(); } while (0)
#define RUN(k, ...) if (IN(k)) { if ((k) == PROBE_PH) { F.dummy = (args.ph_hi > 0); __VA_ARGS__ xcd_barrier(bar); refresh(F); } F.dummy = 0; if ((k) == PROBE_T) TSTAMP(0); __VA_ARGS__ SEAM(k); if ((k) == PROBE_T) { if ((k) == NPHASE - 1) xcd_barrier(bar); TSTAMP(1); } }
    RUN(0, p0_prologue(F, args);)
    RUN(1,
        { Gemm g{(const bf16_t*)args.out, nullptr, (const bf16_t*)(ws + WS_WIN), nullptr, DM, DM, DM, 0, 0};
          StaticOrder S; S.init(T, 6144, F.G, (int)blockIdx.x, 0);
          EpiStore<0, true, true> E{S0, DM, cosT, sinT, nullptr, (float*)(ws + WS_KM)};
          GEMM_BODY<DM, DM, DM, 0, 0, false>(F.lds, g, S, E); }
        { Gemm g{(const bf16_t*)(ws + WS_WIN) + (size_t)6144 * DM, nullptr, (const bf16_t*)args.out, nullptr, DM, DM, DM, 0, 0};
          StaticOrder S; S.init(DM, T, F.G, (int)blockIdx.x, 0);
          EpiStore<0, false, false> E{SL(2), T, nullptr, nullptr, nullptr, nullptr};
          GEMM_BODY<DM, DM, DM, 0, 0, false>(F.lds, g, S, E); })
    RUN(2, p2_conv_kmean(F, args);)
    RUN(3,
        { Gemm g{(const bf16_t*)args.out, nullptr, (const bf16_t*)(ws + WS_WRG), nullptr, DM, 256, 256, 1, 256};
          StaticOrder S; S.init(T, 2048, F.G, (int)blockIdx.x, 0);
          EpiRG E{(const bf16_t*)args.out, (bf16_t*)((unsigned char*)args.out + SLOT_BYTES), SL(3), args.in[7], args.in[9], (const float*)(ws + WS_C8)};
          GEMM_BODY<DM, 256, 256, 1, 256, false>(F.lds, g, S, E); }
        refresh(F); p3_select(F);)
    RUN(4, p45_scan<1>(F);)
    RUN(5, p45_scan<2>(F);)
    RUN(6, p6_attn_sel(F);)
    RUN(7, p7_attn_own(F);)
    RUN(8,
        { Gemm g{SL(0), SL(4), (const bf16_t*)(ws + WS_WBA), (const bf16_t*)(ws + WS_WBL), DM, DM, DM, 0, 0};
        StaticOrder S; S.init(T, DM, F.G, (int)blockIdx.x, 1);
        EpiBranch E{SL(5), SL(6), SL(1)};
        GEMM_BODY<DM, DM, DM, 0, 0, true>(F.lds, g, S, E); })
    RUN(9,
        { Gemm g{SL(1), nullptr, (const bf16_t*)(ws + WS_WOUT), nullptr, DM, DM, DM, 0, 0};
        StaticOrder S; S.init(T, DM, F.G, (int)blockIdx.x, 0);
        EpiStore<0, false, false> E{SL(2), DM, nullptr, nullptr, nullptr, nullptr};
        GEMM_BODY<DM, DM, DM, 0, 0, false>(F.lds, g, S, E); })
    RUN(10, p10_norm_mid(F, args);)
    RUN(11,
        { Gemm g{SL(0), nullptr, (const bf16_t*)(ws + WS_WUP), nullptr, DM, DM, DM, 0, 0};
        StaticOrder S; S.init(T, FF, F.G, (int)blockIdx.x, 0);
        EpiStore<1, false, false> E{SL(3), FF, nullptr, nullptr, (const float*)(ws + WS_RS2), nullptr};
        GEMM_BODY<DM, DM, DM, 0, 0, false>(F.lds, g, S, E); })
    RUN(12,
        { Gemm g{SL(3), nullptr, (const bf16_t*)(ws + WS_WDN), nullptr, FF, FF, FF, 0, 0};
        StaticOrder S; S.init(T, DM, F.G, (int)blockIdx.x, 0);
        EpiStore<0, false, false> E{SL(1), DM, nullptr, nullptr, nullptr, nullptr};
        GEMM_BODY<FF, FF, FF, 0, 0, false>(F.lds, g, S, E); })
    RUN(13, p13_norm_final(F, args);)
    if (PROBE_T >= 0 && blockIdx.x == 0 && threadIdx.x == 0) {
        volatile unsigned long long* ts = (volatile unsigned long long*)(lds + LDS_BYTES - 32);
        const unsigned long long dt = 4ull * (ts[1] - ts[0]), t0 = __builtin_amdgcn_s_memrealtime();
        while (__builtin_amdgcn_s_memrealtime() - t0 < dt) __builtin_amdgcn_s_sleep(8);
    }
}

extern "C" void kernel_launch(void* const* d_in, const int* in_sizes, int n_in, void* d_out, int out_size, void* d_ws, size_t ws_size, hipStream_t stream) {
    static int grid = 0;
    if (grid == 0) {
        if (n_in != 18 || out_size != T * DM || ws_size < WS_END) { fprintf(stderr, "kernel_launch: unexpected shapes (n_in %d out %d ws %zu)\n", n_in, out_size, ws_size); grid = -1; return; }
        int dev = 0, cus = 0;
        if (hipGetDevice(&dev) != hipSuccess || hipDeviceGetAttribute(&cus, hipDeviceAttributeMultiprocessorCount, dev) != hipSuccess) { grid = -1; return; }
        if (hipFuncSetAttribute((const void*)fwd_kernel, hipFuncAttributeMaxDynamicSharedMemorySize, LDS_BYTES) != hipSuccess) { fprintf(stderr, "kernel_launch: hipFuncSetAttribute failed\n"); grid = -1; return; }
        if (cus < 256) { fprintf(stderr, "kernel_launch: built for a 256-CU device (one resident workgroup per CU, 256 workgroups); found %d CUs\n", cus); grid = -1; return; }
        grid = 256;
    }
    if (grid < 0) return;
    Args a{};
    for (int i = 0; i < 18; ++i) a.in[i] = (const float*)d_in[i];
    a.out = (float*)d_out; a.ws = (unsigned char*)d_ws;
#if N_LAUNCH_MODE == 0
    for (int ph = 0; ph < NPHASE; ++ph) {
        a.ph_lo = ph; a.ph_hi = ph + 1;
        hipLaunchKernelGGL(fwd_kernel, dim3(grid), dim3(NTHR), LDS_BYTES, stream, a);
    }
#else
    (void)hipMemsetAsync((char*)d_ws + WS_CTL, 0, 65536, stream);
    a.ph_lo = 0; a.ph_hi = NPHASE;
    hipLaunchKernelGGL(fwd_kernel, dim3(grid), dim3(NTHR), LDS_BYTES, stream, a);
#endif
}
```
